# Optimizing an MI355X kernel written in HIP

```python
import numpy as np
import jax
import jax.numpy as jnp
from jax import lax

D_MODEL = 4096
BATCH = 2
SEQ = 4096
DEPTH = 2

HEAD_DIM = 128
D_MIX = D_MODEL
N_MIX_HEADS = D_MIX // HEAD_DIM
H_MIX = N_MIX_HEADS // 4
NSA_KV = max(1, H_MIX // 4)
NSA_CMP_LEN = 32
NSA_CMP_STRIDE = 16
NSA_CMP_HIDDEN = 256
NSA_SLC_LEN = 64
NSA_TOPK = 16
NSA_WINDOW = 512
DIL_CONFIGS = ((128, 1), (512, 4), (2048, 16))
D_FF = 4 * D_MODEL
PLE_DIM = 256
ROPE_THETA = 10000.0
Q_BLOCK = 128
RMS_EPS = 1e-6
NEG = -1e30
FORCED_SCORE = 1e9

SPLITS = (
    H_MIX * HEAD_DIM,
    NSA_KV * HEAD_DIM, NSA_KV * HEAD_DIM,
    NSA_KV * HEAD_DIM, NSA_KV * HEAD_DIM,
    NSA_KV * HEAD_DIM, NSA_KV * HEAD_DIM,
    H_MIX * 3,
    H_MIX * HEAD_DIM, H_MIX * HEAD_DIM, H_MIX * HEAD_DIM, H_MIX,
    H_MIX * HEAD_DIM, H_MIX * HEAD_DIM, H_MIX * HEAD_DIM,
    H_MIX * HEAD_DIM, H_MIX * HEAD_DIM, H_MIX * HEAD_DIM,
)
N_IN = sum(SPLITS)

kernel_name = "hybrid_nsa_fox_dilated_stickbreak_trunk"


def _rmsnorm(x, g):
    xf = x.astype(jnp.float32)
    y = xf * lax.rsqrt(jnp.mean(xf * xf, axis=-1, keepdims=True) + RMS_EPS)
    return (y * g.astype(jnp.float32)).astype(x.dtype)


def _rope(t, positions):
    half = HEAD_DIM // 2
    inv_freq = ROPE_THETA ** (-jnp.arange(half, dtype=jnp.float32) / half)
    ang = positions.astype(jnp.float32)[..., None] * inv_freq
    cos = jnp.cos(ang)[:, :, None, :]
    sin = jnp.sin(ang)[:, :, None, :]
    tf = t.astype(jnp.float32)
    t1, t2 = tf[..., :half], tf[..., half:]
    return jnp.concatenate([t1 * cos - t2 * sin, t2 * cos + t1 * sin], axis=-1).astype(t.dtype)


def _heads(t, n):
    return t.reshape(t.shape[0], t.shape[1], n, HEAD_DIM)


def _qblock(t, i, axis=1):
    return lax.dynamic_slice_in_dim(t, i * Q_BLOCK, Q_BLOCK, axis=axis)


def _unblock(o):
    o = jnp.moveaxis(o, 0, 1)
    return o.reshape((o.shape[0], o.shape[1] * o.shape[2]) + o.shape[3:])


def _nsa_attention(q, k_cmp, v_cmp, k_slc, v_slc, k_win, v_win, gate_logits,
                   cmp_pe_k, cmp_w1_k, cmp_w2_k, cmp_pe_v, cmp_w1_v, cmp_w2_v):
    B, S, H, D = q.shape
    G = k_cmp.shape[2]
    hpg = H // G
    scale = D ** -0.5
    qg = q.reshape(B, S, G, hpg, D)
    tpos = jnp.arange(S)

    n_cmp = (S - NSA_CMP_LEN) // NSA_CMP_STRIDE + 1
    blk = np.arange(n_cmp)[:, None] * NSA_CMP_STRIDE + np.arange(NSA_CMP_LEN)[None, :]

    def compress(t, pe, w1, w2):
        tb = jnp.take(t, blk, axis=1) + pe[None, None, :, None, :]
        tb = tb.transpose(0, 1, 3, 2, 4).reshape(B, n_cmp, G, NSA_CMP_LEN * D)
        return jax.nn.gelu(tb @ w1) @ w2

    kc = compress(k_cmp, cmp_pe_k, cmp_w1_k, cmp_w2_k)
    vc = compress(v_cmp, cmp_pe_v, cmp_w1_v, cmp_w2_v)
    visible = jnp.asarray(blk[:, -1])[None, :] <= tpos[:, None]
    s = jnp.einsum('bsghd,bcgd->bghsc', qg, kc).astype(jnp.float32) * scale
    s = jnp.where(visible, s, NEG)
    p_cmp = jnp.where(visible, jax.nn.softmax(s, axis=-1), 0.0)
    o_cmp = jnp.einsum('bghsc,bcgd->bsghd', p_cmp.astype(vc.dtype), vc).reshape(B, S, H, D)

    n_slc = S // NSA_SLC_LEN
    ratio = NSA_SLC_LEN // NSA_CMP_STRIDE
    span = NSA_CMP_LEN // NSA_CMP_STRIDE
    jj, mm, nn = np.meshgrid(np.arange(n_slc), np.arange(ratio), np.arange(span), indexing='ij')
    cc = ratio * jj + mm + nn
    keep = cc < n_cmp
    cmp_to_slc = np.zeros((n_cmp, n_slc), np.float32)
    np.add.at(cmp_to_slc, (cc[keep], jj[keep]), 1.0)
    imp = jnp.einsum('bghsc,cj->bgsj', p_cmp, jnp.asarray(cmp_to_slc))
    jblk = jnp.arange(n_slc)[None, :]
    cur = (tpos // NSA_SLC_LEN)[:, None]
    forced = (jblk == 0) | (jblk == cur) | (jblk == cur - 1)
    causal_blk = jblk * NSA_SLC_LEN <= tpos[:, None]
    score = jnp.where(causal_blk, jnp.where(forced, FORCED_SCORE, imp), -1.0)
    k_top = min(NSA_TOPK, n_slc)
    _, sel = lax.top_k(score, k_top)

    k_slc_t = k_slc.transpose(0, 2, 1, 3)
    v_slc_t = v_slc.transpose(0, 2, 1, 3)
    bi = jnp.arange(B)[:, None, None]
    gi = jnp.arange(G)[None, :, None]
    n_sel_tok = k_top * NSA_SLC_LEN
    k_win_p = jnp.pad(k_win, ((0, 0), (NSA_WINDOW, 0), (0, 0), (0, 0)))
    v_win_p = jnp.pad(v_win, ((0, 0), (NSA_WINDOW, 0), (0, 0), (0, 0)))

    def block(i):
        t0 = i * Q_BLOCK
        tq = t0 + jnp.arange(Q_BLOCK)
        qb = _qblock(qg, i)
        selb = _qblock(sel, i, axis=2)
        pos = (selb[..., None] * NSA_SLC_LEN + jnp.arange(NSA_SLC_LEN)).reshape(B, G, Q_BLOCK * n_sel_tok)
        kg = k_slc_t[bi, gi, pos].reshape(B, G, Q_BLOCK, n_sel_tok, D)
        vg = v_slc_t[bi, gi, pos].reshape(B, G, Q_BLOCK, n_sel_tok, D)
        m_sel = pos.reshape(B, G, Q_BLOCK, n_sel_tok) <= tq[None, None, :, None]
        ss = jnp.einsum('bqghd,bgqnd->bghqn', qb, kg).astype(jnp.float32) * scale
        ps = jax.nn.softmax(jnp.where(m_sel[:, :, None], ss, NEG), axis=-1)
        o_s = jnp.einsum('bghqn,bgqnd->bqghd', ps.astype(vg.dtype), vg)
        kw = lax.dynamic_slice_in_dim(k_win_p, t0, NSA_WINDOW + Q_BLOCK, axis=1)
        vw = lax.dynamic_slice_in_dim(v_win_p, t0, NSA_WINDOW + Q_BLOCK, axis=1)
        kwpos = t0 - NSA_WINDOW + jnp.arange(NSA_WINDOW + Q_BLOCK)
        dist = tq[:, None] - kwpos[None, :]
        m_win = (dist >= 0) & (dist < NSA_WINDOW) & (kwpos[None, :] >= 0)
        sw = jnp.einsum('bqghd,bkgd->bghqk', qb, kw).astype(jnp.float32) * scale
        pw = jax.nn.softmax(jnp.where(m_win, sw, NEG), axis=-1)
        o_w = jnp.einsum('bghqk,bkgd->bqghd', pw.astype(vw.dtype), vw)
        return o_s.reshape(B, Q_BLOCK, H, D), o_w.reshape(B, Q_BLOCK, H, D)

    o_slc, o_win = lax.map(block, jnp.arange(S // Q_BLOCK))
    o_slc, o_win = _unblock(o_slc), _unblock(o_win)
    g = jax.nn.sigmoid(gate_logits.astype(jnp.float32))
    out = g[..., 0:1] * o_cmp + g[..., 1:2] * o_slc + g[..., 2:3] * o_win
    return out.astype(q.dtype)


def _fox_attention(q, k, v, log_f):
    B, S, H, D = q.shape
    scale = D ** -0.5
    c = jnp.cumsum(log_f, axis=1).transpose(0, 2, 1)
    kpos = jnp.arange(S)

    def block(i):
        tq = i * Q_BLOCK + jnp.arange(Q_BLOCK)
        qb = _qblock(q, i)
        cb = _qblock(c, i, axis=2)
        s = jnp.einsum('bqhd,bkhd->bhqk', qb, k).astype(jnp.float32) * scale
        s = s + cb[..., None] - c[:, :, None, :]
        s = jnp.where(tq[:, None] >= kpos[None, :], s, NEG)
        p = jax.nn.softmax(s, axis=-1)
        return jnp.einsum('bhqk,bkhd->bqhd', p.astype(v.dtype), v)

    return _unblock(lax.map(block, jnp.arange(S // Q_BLOCK)))


def _dilated_attention(q, k, v):
    B, S, H, D = q.shape
    scale = D ** -0.5

    def block(i):
        tq = i * Q_BLOCK + jnp.arange(Q_BLOCK)
        qb = _qblock(q, i)
        lses, outs = [], []
        for window, dil in DIL_CONFIGS:
            offs = dil * jnp.arange(window // dil + 1)
            idx = tq[:, None] - offs[None, :]
            valid = idx >= 0
            idx = jnp.maximum(idx, 0)
            kg = jnp.take(k, idx, axis=1)
            vg = jnp.take(v, idx, axis=1)
            s = jnp.einsum('bqhd,bqwhd->bhqw', qb, kg).astype(jnp.float32) * scale
            s = jnp.where(valid[None, None], s, NEG)
            lse = jax.nn.logsumexp(s, axis=-1)
            p = jnp.exp(s - lse[..., None])
            outs.append(jnp.einsum('bhqw,bqwhd->bqhd', p.astype(vg.dtype), vg))
            lses.append(lse)
        w = jax.nn.softmax(jnp.stack(lses, axis=0), axis=0)
        w = w.transpose(0, 1, 3, 2)[..., None]
        o = jnp.sum(jnp.stack(outs, axis=0).astype(jnp.float32) * w, axis=0)
        return o.astype(v.dtype)

    return _unblock(lax.map(block, jnp.arange(S // Q_BLOCK)))


def _stick_breaking_attention(q, k, v):
    B, S, H, D = q.shape
    scale = D ** -0.5
    kpos = jnp.arange(S)

    def block(i):
        tq = i * Q_BLOCK + jnp.arange(Q_BLOCK)
        qb = _qblock(q, i)
        z = jnp.einsum('bqhd,bkhd->bhqk', qb, k).astype(jnp.float32) * scale
        strict = tq[:, None] > kpos[None, :]
        log1m = jnp.where(strict, jax.nn.log_sigmoid(-z), 0.0)
        after = lax.cumsum(log1m, axis=3, reverse=True) - log1m
        a = jnp.where(strict, jnp.exp(jax.nn.log_sigmoid(z) + after), 0.0)
        return jnp.einsum('bhqk,bkhd->bqhd', a.astype(v.dtype), v)

    return _unblock(lax.map(block, jnp.arange(S // Q_BLOCK)))


def _layer(h, p_i, positions, norm_attn, w_in, fox_bf, cmp_pe_k, cmp_w1_k, cmp_w2_k,
           cmp_pe_v, cmp_w1_v, cmp_w2_v, w_o, norm_mlp, w_up, w_down, norm_ple, w_ple_gate, w_ple_proj):
    B, S, _ = h.shape
    x = _rmsnorm(h, norm_attn)
    proj = x @ w_in
    (q_a, kc_a, vc_a, ks_a, vs_a, kw_a, vw_a, g_a,
     q_b, k_b, v_b, f_b,
     q_c, k_c, v_c,
     q_d, k_d, v_d) = jnp.split(proj, np.cumsum(SPLITS)[:-1].tolist(), axis=-1)

    o_a = _nsa_attention(
        _rope(_heads(q_a, H_MIX), positions),
        _heads(kc_a, NSA_KV), _heads(vc_a, NSA_KV),
        _rope(_heads(ks_a, NSA_KV), positions), _heads(vs_a, NSA_KV),
        _rope(_heads(kw_a, NSA_KV), positions), _heads(vw_a, NSA_KV),
        g_a.reshape(B, S, H_MIX, 3),
        cmp_pe_k, cmp_w1_k, cmp_w2_k, cmp_pe_v, cmp_w1_v, cmp_w2_v)
    log_f = jax.nn.log_sigmoid(f_b.astype(jnp.float32) + fox_bf.astype(jnp.float32))
    o_b = _fox_attention(_heads(q_b, H_MIX), _heads(k_b, H_MIX), _heads(v_b, H_MIX), log_f)
    o_c = _dilated_attention(_rope(_heads(q_c, H_MIX), positions),
                             _rope(_heads(k_c, H_MIX), positions), _heads(v_c, H_MIX))
    o_d = _stick_breaking_attention(_heads(q_d, H_MIX), _heads(k_d, H_MIX), _heads(v_d, H_MIX))

    mix = jnp.concatenate([o.reshape(B, S, H_MIX * HEAD_DIM) for o in (o_a, o_b, o_c, o_d)], axis=-1)
    h = h + mix @ w_o

    x2 = _rmsnorm(h, norm_mlp)
    h = h + jnp.square(jax.nn.relu(x2 @ w_up)) @ w_down

    gate = jax.nn.sigmoid(_rmsnorm(h, norm_ple) @ w_ple_gate)
    h = h + gate * (p_i @ w_ple_proj)
    return h


def setup_inputs(seed: int = 0) -> dict:
    key = jax.random.key(seed)
    ks = jax.random.split(key, 24)
    f32 = jnp.float32

    def nrm(k, shape, fan_in):
        return jax.random.normal(k, shape, f32) * (fan_in ** -0.5)

    def gain(k, shape):
        return 1.0 + 0.05 * jax.random.normal(k, shape, f32)

    L, Dh = NSA_CMP_LEN, HEAD_DIM
    positions = (jnp.arange(SEQ, dtype=jnp.int32)[None, :]
                 + jax.random.randint(ks[2], (BATCH, 1), 0, 1024, dtype=jnp.int32))
    return {
        "x": jax.random.normal(ks[0], (BATCH, SEQ, D_MODEL), f32),
        "p": jax.random.normal(ks[1], (DEPTH, BATCH, SEQ, PLE_DIM), f32),
        "positions": positions,
        "norm_attn": gain(ks[3], (DEPTH, D_MODEL)),
        "w_in": nrm(ks[4], (DEPTH, D_MODEL, N_IN), D_MODEL),
        "fox_bf": 3.0 + 0.5 * jax.random.normal(ks[5], (DEPTH, H_MIX), f32),
        "cmp_pe_k": 0.5 * jax.random.normal(ks[6], (DEPTH, L, Dh), f32),
        "cmp_w1_k": nrm(ks[7], (DEPTH, L * Dh, NSA_CMP_HIDDEN), L * Dh),
        "cmp_w2_k": nrm(ks[8], (DEPTH, NSA_CMP_HIDDEN, Dh), NSA_CMP_HIDDEN),
        "cmp_pe_v": 0.5 * jax.random.normal(ks[9], (DEPTH, L, Dh), f32),
        "cmp_w1_v": nrm(ks[10], (DEPTH, L * Dh, NSA_CMP_HIDDEN), L * Dh),
        "cmp_w2_v": nrm(ks[11], (DEPTH, NSA_CMP_HIDDEN, Dh), NSA_CMP_HIDDEN),
        "w_o": nrm(ks[12], (DEPTH, D_MIX, D_MODEL), D_MIX),
        "norm_mlp": gain(ks[13], (DEPTH, D_MODEL)),
        "w_up": nrm(ks[14], (DEPTH, D_MODEL, D_FF), D_MODEL),
        "w_down": nrm(ks[15], (DEPTH, D_FF, D_MODEL), D_FF),
        "norm_ple": gain(ks[16], (DEPTH, D_MODEL)),
        "w_ple_gate": nrm(ks[17], (DEPTH, D_MODEL, D_MODEL), D_MODEL),
        "w_ple_proj": nrm(ks[18], (DEPTH, PLE_DIM, D_MODEL), PLE_DIM),
        "norm_final": gain(ks[19], (D_MODEL,)),
    }


def reference(x, p, positions, norm_attn, w_in, fox_bf, cmp_pe_k, cmp_w1_k, cmp_w2_k,
              cmp_pe_v, cmp_w1_v, cmp_w2_v, w_o, norm_mlp, w_up, w_down, norm_ple,
              w_ple_gate, w_ple_proj, norm_final):
    h = x
    for i in range(DEPTH):
        h = _layer(h, p[i], positions, norm_attn[i], w_in[i], fox_bf[i],
                   cmp_pe_k[i], cmp_w1_k[i], cmp_w2_k[i], cmp_pe_v[i], cmp_w1_v[i], cmp_w2_v[i],
                   w_o[i], norm_mlp[i], w_up[i], w_down[i], norm_ple[i], w_ple_gate[i], w_ple_proj[i])
    return _rmsnorm(h, norm_final)
```

```cpp
#include <hip/hip_runtime.h>
#include <cstdio>
#include <cstdint>
#include <cmath>
namespace pg8 {
#define PG8_LAS __attribute__((address_space(3)))
typedef unsigned short bf16_t;
typedef short bf16x8 __attribute__((ext_vector_type(8)));
typedef float f32x4 __attribute__((ext_vector_type(4)));
typedef unsigned u32x4 __attribute__((ext_vector_type(4)));
typedef int i32x4_t __attribute__((ext_vector_type(4)));
typedef int i32x8_t __attribute__((ext_vector_type(8)));
constexpr int BM = 256, BK = 64, HALF = 128, HTB = HALF * BK * 2  , STAGE_BYTES = 8 * HTB, NXCD = 8, WGM = 8;

__host__ __device__ __forceinline__ int lds_byte(int r, int c) { const int st = (r >> 4) * 2 + (c >> 5), rr = r & 15, cc = c & 31, ob = rr * 64 + cc * 2; return st * 1024 + (ob ^ (((ob >> 9) & 1) << 5)); }
__host__ __device__ __forceinline__ void stage_rc(int b, int& R, int& C) { const int st = b / 1024, sb = b % 1024, swz = sb ^ (((sb >> 9) & 1) << 5); R = (st >> 1) * 16 + swz / 64; C = (st & 1) * 32 + (swz % 64) / 2; }
__host__ __device__ __forceinline__ int perm32(int rho) { const int n = rho >> 4, i = rho & 15; return 8 * (i >> 2) + 4 * n + (i & 3); }

struct Unit { int pm, pn, idx; };
struct Gemm { const bf16_t* A; const bf16_t* Bt; int M, N, K; int lda = 0, ldb = 0; };

struct StaticOrder {
    int nM, nN, nwg, G, c;
    __host__ __device__ void init(int M, int N, int G_, int c_) { nM = M / BM; nN = N / BM; nwg = nM * nN; G = G_; c = c_; }
    __host__ __device__ bool next(int i, Unit& u) const {
        const long L = (long)i * G + c; if (L >= nwg) return false;
        int wgid = (int)L; { const int q = nwg / NXCD, r = nwg % NXCD, xcd = wgid % NXCD, off = wgid / NXCD; wgid = (xcd < r ? xcd * (q + 1) : r * (q + 1) + (xcd - r) * q) + off; }
        const int nig = WGM * nN, gid = wgid / nig, fm = gid * WGM, gsz = (nM - fm) < WGM ? (nM - fm) : WGM;
        u.pm = fm + ((wgid % nig) % gsz); u.pn = (wgid % nig) / gsz; u.idx = i; return true;
    }
    __device__ __forceinline__ void a_ready(const Unit&) const {}
    __device__ __forceinline__ void done(const Unit&) const {}
};

__device__ __forceinline__ unsigned cvt_pk_bf16(float lo, float hi) { unsigned r; asm volatile("v_cvt_pk_bf16_f32 %0, %1, %2" : "=v"(r) : "v"(lo), "v"(hi)); return r; }
typedef float f32x2 __attribute__((ext_vector_type(2)));
__device__ __forceinline__ f32x2 gelu_pk(f32x2 v) {
    const f32x2 av = __builtin_elementwise_abs(v), d = av * 0.2316418882f + 1.0f;
    f32x2 t; t.x = __builtin_amdgcn_rcpf(d.x); t.y = __builtin_amdgcn_rcpf(d.y);
    f32x2 q = t * 0.5307027145f + (-0.7265760135f); q = q * t + 0.7107068705f; q = q * t + (-0.142248368f); q = q * t + 0.127414796f; q = q * t;
    const f32x2 s = (v * v) * (-0.72134752044f);
    f32x2 e; e.x = __builtin_amdgcn_exp2f(s.x); e.y = __builtin_amdgcn_exp2f(s.y);
    const f32x2 m = v * (q * e), r = v - m;
    f32x2 o; o.x = v.x < 0.f ? m.x : r.x; o.y = v.y < 0.f ? m.y : r.y; return o;
}

template <class Epi, class Sched, bool ALIGN_EPI = false, bool SP2 = false, bool F8 = false, int SCALE_B = 0x7F7F7F7F>
__device__ __forceinline__ void gemm_phase(PG8_LAS unsigned char* lds, const Gemm g, const Sched& S, const Epi& E) {
    int tid_ = threadIdx.x; asm volatile("" : "+v"(tid_));
    const int tid = tid_, wid = __builtin_amdgcn_readfirstlane(tid >> 6), lane = tid & 63, wr = wid >> 2, wc = wid & 3, fr = lane & 15, fq = lane >> 4;
    int K_ = g.K; asm volatile("" : "+s"(K_)); const int K = K_, nt = K / (F8 ? 2 * BK : BK); constexpr int ESZ = F8 ? 1 : 2;
    const int lda = g.lda ? g.lda : K, ldb = g.ldb ? g.ldb : K;
    unsigned voffA[2], voffB[2];
#pragma unroll
    for (int i = 0; i < 2; ++i) { int R, C; stage_rc(tid * 16 + i * 8192, R, C); const int Rb = Epi::PERM ? ((R & ~31) + perm32(R & 31)) : R;
        voffA[i] = F8 ? (unsigned)(R * lda + 2 * C) : (unsigned)(R * lda + C) * 2u; voffB[i] = F8 ? (unsigned)(Rb * ldb + 2 * C) : (unsigned)(Rb * ldb + C) * 2u; }
    const size_t kstep = (size_t)(BK * 2);
    const size_t hstepA = (size_t)HALF * lda * ESZ, hstepB = (size_t)HALF * ldb * ESZ;
    const size_t tstepA = 2 * hstepA, tstepB = 2 * hstepB;
    const unsigned ldsw = (unsigned)wid * 1024u;
    const int aoff = lds_byte(wr * 64 + fr, fq * 8), boff = lds_byte(wc * 32 + fr, fq * 8);
#define PG8_SA(b, h) (((b) * 2 + (h)) * HTB)
#define PG8_SB(b, h) ((4 + (b) * 2 + (h)) * HTB)
#define PG8_STAGE(bufoff, gbase, voff) do { _Pragma("unroll") for (int _i = 0; _i < 2; ++_i) \
        __builtin_amdgcn_global_load_lds((const unsigned*)((const char*)(gbase) + (voff)[_i]), (PG8_LAS unsigned*)(lds + (bufoff) + ldsw + _i * 8192), 16, 0, 0); } while (0)
#define PG8_LDA(dst, b, h) do { _Pragma("unroll") for (int m = 0; m < 4; ++m) _Pragma("unroll") for (int k = 0; k < 2; ++k) dst[m][k] = *(const PG8_LAS bf16x8*)(lds + PG8_SA(b, h) + aoff + m * 2048 + k * 1024); } while (0)
#define PG8_LDB(dst, b, h) do { _Pragma("unroll") for (int n = 0; n < 2; ++n) _Pragma("unroll") for (int k = 0; k < 2; ++k) dst[n][k] = *(const PG8_LAS bf16x8*)(lds + PG8_SB(b, h) + boff + n * 2048 + k * 1024); } while (0)
#define PG8_CAT8(x, y) __builtin_shufflevector(__builtin_bit_cast(i32x4_t, x), __builtin_bit_cast(i32x4_t, y), 0, 1, 2, 3, 4, 5, 6, 7)
#define PG8_MMA(ai, bj, At, Bt) do { __builtin_amdgcn_s_setprio(1); if constexpr (F8) { i32x8_t a8_[4], b8_[2]; _Pragma("unroll") for (int m = 0; m < 4; ++m) a8_[m] = PG8_CAT8(At[m][0], At[m][1]); _Pragma("unroll") for (int n = 0; n < 2; ++n) b8_[n] = PG8_CAT8(Bt[n][0], Bt[n][1]); \
        _Pragma("unroll") for (int m = 0; m < 4; ++m) _Pragma("unroll") for (int n = 0; n < 2; ++n) \
        asm volatile("v_mfma_scale_f32_16x16x128_f8f6f4 %0, %1, %2, %0, %3, %4 op_sel_hi:[0,0,0]" : "+v"(acc[ai][bj][m][n]) : "v"(b8_[n]), "v"(a8_[m]), "v"(sclB_), "v"(sclA_)); } \
    else { _Pragma("unroll") for (int m = 0; m < 4; ++m) _Pragma("unroll") for (int n = 0; n < 2; ++n) _Pragma("unroll") for (int k = 0; k < 2; ++k) \
        acc[ai][bj][m][n] = __builtin_amdgcn_mfma_f32_16x16x32_bf16(Bt[n][k], At[m][k], acc[ai][bj][m][n], 0, 0, 0); } __builtin_amdgcn_s_setprio(0); } while (0)
#define PG8_WAIT_V(n) asm volatile("s_waitcnt vmcnt(" #n ")" ::: "memory")
#define PG8_WAIT_L(n) asm volatile("s_waitcnt lgkmcnt(" #n ")" ::: "memory")
#define PG8_BAR __builtin_amdgcn_s_barrier()
#define PG8_SCHED __builtin_amdgcn_sched_barrier(0)
    int sclA_ = 0x7F7F7F7F, sclB_ = SCALE_B; if constexpr (F8) { asm volatile("" : "+v"(sclA_), "+v"(sclB_)); }
    Unit cur, nxt; int ui = 0;
    if (!S.next(0, cur)) return;
    f32x4 acc[2][2][4][2];
#pragma unroll
    for (int a = 0; a < 2; ++a)
#pragma unroll
        for (int b = 0; b < 2; ++b)
#pragma unroll
            for (int m = 0; m < 4; ++m)
#pragma unroll
                for (int n = 0; n < 2; ++n) acc[a][b][m][n] = (f32x4){0.f, 0.f, 0.f, 0.f};
    bf16x8 At[4][2], B0[2][2], B1[2][2];
    const char* cA = (const char*)g.A + (size_t)cur.pm * tstepA; const char* cB = (const char*)g.Bt + (size_t)cur.pn * tstepB;
    S.a_ready(cur);
    if constexpr (SP2) {
        PG8_STAGE(PG8_SB(0, 0), cB, voffB); PG8_STAGE(PG8_SB(0, 1), cB + hstepB, voffB); PG8_STAGE(PG8_SA(0, 0), cA, voffA); PG8_STAGE(PG8_SA(0, 1), cA + hstepA, voffA);
        if (wr == 1) PG8_BAR;
        PG8_WAIT_V(2); PG8_BAR;
        PG8_STAGE(PG8_SB(1, 0), cB + kstep, voffB); PG8_STAGE(PG8_SA(1, 0), cA + kstep, voffA); PG8_STAGE(PG8_SB(1, 1), cB + hstepB + kstep, voffB);
        PG8_WAIT_V(6); PG8_BAR;
    } else {
        PG8_STAGE(PG8_SB(0, 0), cB, voffB); PG8_STAGE(PG8_SA(0, 0), cA, voffA); PG8_STAGE(PG8_SB(0, 1), cB + hstepB, voffB); PG8_STAGE(PG8_SA(0, 1), cA + hstepA, voffA);
        if (wr == 1) PG8_BAR;
        PG8_WAIT_V(4); PG8_BAR;
        PG8_STAGE(PG8_SB(1, 0), cB + kstep, voffB); PG8_STAGE(PG8_SA(1, 0), cA + kstep, voffA); PG8_STAGE(PG8_SB(1, 1), cB + hstepB + kstep, voffB);
        PG8_WAIT_V(6); PG8_BAR;
    }
    for (;;) {
        const bool has_next = S.next(ui + 1, nxt);
        const char* nA = has_next ? (const char*)g.A + (size_t)nxt.pm * tstepA : cA; const char* nB = has_next ? (const char*)g.Bt + (size_t)nxt.pn * tstepB : cB;
        for (int t = 0; t < nt; t += 2) {
            const bool last = (t == nt - 2);
            const char* a1 = cA + (size_t)(t + 1) * kstep;
            const char* a2 = last ? nA : cA + (size_t)(t + 2) * kstep; const char* b2 = last ? nB : cB + (size_t)(t + 2) * kstep;
            const char* a3 = a2 + kstep; const char* b3 = b2 + kstep;
            if (last && has_next) S.a_ready(nxt);
            if constexpr (SP2) {
            PG8_LDB(B0, 0, 0); PG8_LDB(B1, 0, 1); PG8_SCHED; PG8_LDA(At, 0, 0); PG8_STAGE(PG8_SA(1, 1), a1 + hstepA, voffA);
            PG8_WAIT_V(8); PG8_WAIT_L(0); PG8_BAR; PG8_MMA(0, 0, At, B0); PG8_MMA(0, 1, At, B1); PG8_BAR; PG8_SCHED;
            PG8_LDA(At, 0, 1); PG8_STAGE(PG8_SB(0, 0), b2, voffB); PG8_STAGE(PG8_SB(0, 1), b2 + hstepB, voffB); PG8_STAGE(PG8_SA(0, 0), a2, voffA);
            PG8_WAIT_V(8); PG8_WAIT_L(0); PG8_BAR; PG8_MMA(1, 0, At, B0); PG8_MMA(1, 1, At, B1); PG8_BAR; PG8_SCHED;
            PG8_LDB(B0, 1, 0); PG8_LDB(B1, 1, 1); PG8_SCHED; PG8_LDA(At, 1, 0); PG8_STAGE(PG8_SA(0, 1), a2 + hstepA, voffA);
            PG8_WAIT_V(8); PG8_WAIT_L(0); PG8_BAR; PG8_MMA(0, 0, At, B0); PG8_MMA(0, 1, At, B1); PG8_BAR; PG8_SCHED;
            PG8_LDA(At, 1, 1); PG8_STAGE(PG8_SB(1, 0), b3, voffB); PG8_STAGE(PG8_SB(1, 1), b3 + hstepB, voffB); PG8_STAGE(PG8_SA(1, 0), a3, voffA);
            PG8_WAIT_V(8); PG8_WAIT_L(0); PG8_BAR; PG8_MMA(1, 0, At, B0); PG8_MMA(1, 1, At, B1); PG8_BAR; PG8_SCHED;
            } else {
            PG8_LDB(B0, 0, 0); PG8_SCHED; PG8_LDA(At, 0, 0); PG8_STAGE(PG8_SA(1, 1), a1 + hstepA, voffA);
            PG8_WAIT_L(8); PG8_BAR; PG8_WAIT_L(0); PG8_MMA(0, 0, At, B0); PG8_BAR; PG8_SCHED;
            PG8_LDB(B1, 0, 1); PG8_STAGE(PG8_SB(0, 0), b2, voffB);
            PG8_BAR; PG8_WAIT_L(0); PG8_MMA(0, 1, At, B1); PG8_BAR;
            PG8_LDA(At, 0, 1); PG8_STAGE(PG8_SA(0, 0), a2, voffA);
            PG8_BAR; PG8_WAIT_L(0); PG8_MMA(1, 0, At, B0); PG8_BAR; PG8_SCHED;
            PG8_STAGE(PG8_SB(0, 1), b2 + hstepB, voffB);
            PG8_WAIT_V(6); PG8_BAR; PG8_MMA(1, 1, At, B1); PG8_BAR;
            PG8_LDB(B0, 1, 0); PG8_SCHED; PG8_LDA(At, 1, 0); PG8_STAGE(PG8_SA(0, 1), a2 + hstepA, voffA);
            PG8_WAIT_L(8); PG8_BAR; PG8_WAIT_L(0); PG8_MMA(0, 0, At, B0); PG8_BAR; PG8_SCHED;
            PG8_LDB(B1, 1, 1); PG8_STAGE(PG8_SB(1, 0), b3, voffB);
            PG8_BAR; PG8_WAIT_L(0); PG8_MMA(0, 1, At, B1); PG8_BAR;
            PG8_LDA(At, 1, 1); PG8_STAGE(PG8_SA(1, 0), a3, voffA);
            PG8_BAR; PG8_WAIT_L(0); PG8_MMA(1, 0, At, B0); PG8_BAR; PG8_SCHED;
            PG8_STAGE(PG8_SB(1, 1), b3 + hstepB, voffB);
            PG8_WAIT_V(6); PG8_BAR; PG8_MMA(1, 1, At, B1); PG8_BAR;
            }
        }
        if constexpr (F8) asm volatile("s_nop 15\n\ts_nop 15" ::: "memory");
        if constexpr (ALIGN_EPI) { if (wr == 0) PG8_BAR; }
        if constexpr (!Epi::AFTER_DRAIN) { E(acc, cur, wr, wc, fr, fq);
#ifdef DOUBLE_EPI
            if constexpr (Epi::IDEMPOTENT) { asm volatile("" ::: "memory"); E(acc, cur, wr, wc, fr, fq); }
#endif
            S.done(cur); }
        if (!has_next) break;
#pragma unroll
        for (int a = 0; a < 2; ++a)
#pragma unroll
            for (int b = 0; b < 2; ++b)
#pragma unroll
                for (int m = 0; m < 4; ++m)
#pragma unroll
                    for (int n = 0; n < 2; ++n) acc[a][b][m][n] = (f32x4){0.f, 0.f, 0.f, 0.f};
        cur = nxt; cA = nA; cB = nB; ++ui;
        if constexpr (ALIGN_EPI) { if (wr == 1) PG8_BAR; }
    }
    PG8_WAIT_V(0);
    if constexpr (!ALIGN_EPI) { if (wr == 0) PG8_BAR; }
    PG8_BAR;
    if constexpr (Epi::AFTER_DRAIN) { E.fused(acc, cur, wr, wc, fr, fq, lds, wid, lane); S.done(cur); }
#undef PG8_SA
#undef PG8_SB
#undef PG8_STAGE
#undef PG8_LDA
#undef PG8_LDB
#undef PG8_MMA
#undef PG8_CAT8
#undef PG8_WAIT_V
#undef PG8_WAIT_L
#undef PG8_BAR
#undef PG8_SCHED
}
}

constexpr int NB = 2, SEQ = 4096, DM = 4096, MROWS = NB * SEQ, HD = 128, NHB = 92, NPROJ = 12032, NIN = 11808, DFF = 16384, PLE = 256, DEPTH = 2;
constexpr int NCMP = 255;
constexpr float RMS_EPS = 1e-6f;
constexpr float QK_SCALE = 0.08838834764831845f;
constexpr int NWAVES = 8, NTHREADS = 512;
constexpr int HB_QA = 0, HB_KC = 8, HB_VC = 10, HB_KS = 12, HB_VS = 14, HB_KW = 16, HB_VW = 18, HB_QB = 20, HB_KB = 28, HB_VB = 36, HB_QC = 44, HB_KCC = 52, HB_VCC = 60, HB_QD = 68, HB_KD = 76, HB_VD = 84;
__host__ __device__ __forceinline__ bool hb_is_rope(int hb) { return hb < 8 || hb == 12 || hb == 13 || hb == 16 || hb == 17 || (hb >= 44 && hb < 60); }

constexpr size_t MiB = 1u << 20;
constexpr size_t WS_CTL = 0, CTL_ZERO_BYTES = 1 * MiB;
constexpr size_t WS_ROPE = 1 * MiB;
constexpr size_t WS_GATE = 6 * MiB;
constexpr size_t WS_CUM = 7 * MiB;
constexpr size_t WS_KC = 8 * MiB;
constexpr size_t WS_VC = 8 * MiB + 512 * 1024;
constexpr size_t WS_SSA = 12 * MiB, WS_SSB = 14 * MiB;
constexpr size_t WS_CBP = 11 * MiB;
constexpr size_t WS_HID = 10 * MiB;
constexpr size_t WS_SEL = 9 * MiB;
constexpr size_t WS_PB = 16 * MiB;
constexpr size_t WS_W = 32 * MiB;
constexpr size_t W_IN = 0, W_O = 94 * MiB, W_UP = 126 * MiB, W_DN = 254 * MiB, W_G = 382 * MiB, W_PP = 414 * MiB, W_C1K = 416 * MiB, W_C1V = 418 * MiB, W_C2K = 420 * MiB, W_C2V = 420 * MiB + 65536, LAYER_W = 424 * MiB;
constexpr size_t WS_XN = 896 * MiB;
constexpr size_t WS_QKV = 960 * MiB;
constexpr size_t WS_OCMP = 1144 * MiB;
constexpr size_t WS_MIX = 1176 * MiB;
constexpr size_t WS_H = 1240 * MiB;
constexpr size_t WS_FF = 1368 * MiB;
constexpr size_t WS_XN8 = WS_FF;
constexpr size_t WS_PP = 1624 * MiB;
constexpr size_t WS_DO = 1688 * MiB;
constexpr size_t WS_LSE = 1784 * MiB;
constexpr size_t WS_OS = 1785 * MiB;
constexpr size_t WS_XN2 = 1817 * MiB;
constexpr size_t WS_END = 1881 * MiB;
static_assert(WS_W + 2 * LAYER_W <= WS_XN, "ws map");
static_assert((size_t)NPROJ * DM * 2 <= W_O, "ws map");
constexpr int N8P = 23, N16P = 24;
__constant__ unsigned char P8MAP[N8P] = {0,1,2,3,4,6,8,10,11,12,13,14,15,16,17,22,23,24,25,26,27,28,29};
__constant__ unsigned char P16MAP[N16P] = {5,7,9,18,19,20,21,30,31,32,33,34,35,36,37,38,39,40,41,42,43,44,45,46};
__constant__ unsigned char PTYPE[47] = {128,129,130,131,132,0,133,1,134,2,135,136,137,138,139,140,141,142,3,4,5,6,143,144,145,146,147,148,149,150,7,8,9,10,11,12,13,14,15,16,17,18,19,20,21,22,23};
constexpr size_t W_IN8 = 52 * MiB;
static_assert((size_t)N16P * 256 * 4096 * 2 <= W_IN8 && W_IN8 + (size_t)N8P * 256 * 4096 <= W_O, "w_in split");
constexpr int CW_BAR = 4096, CW_CBIAS = 16384;

constexpr int RING_OFF = 0, RING_BYTES = 131072;
constexpr int LDSCTL_OFF = RING_BYTES, MISC_OFF = LDSCTL_OFF + 320;
constexpr int LDS_BYTES = 147456;

#define GAS __attribute__((address_space(1)))
#define LAS __attribute__((address_space(3)))
typedef unsigned short bf16;
typedef unsigned v4u __attribute__((ext_vector_type(4)));
typedef unsigned v2u __attribute__((ext_vector_type(2)));
typedef float f32x4 __attribute__((ext_vector_type(4)));
typedef float f32x2 __attribute__((ext_vector_type(2)));
#define LDS_WAIT() asm volatile("s_waitcnt lgkmcnt(0)" ::: "memory")
#define VM_WAIT() asm volatile("s_waitcnt vmcnt(0)" ::: "memory")
__device__ __forceinline__ unsigned f2bf(float f) { unsigned u = __builtin_bit_cast(unsigned, f); return (u + 0x7fffu + ((u >> 16) & 1u)) >> 16; }
__device__ __forceinline__ unsigned pk2(float lo, float hi) { return f2bf(lo) | (f2bf(hi) << 16); }
__device__ __forceinline__ float bflo(unsigned u) { return __builtin_bit_cast(float, u << 16); }
__device__ __forceinline__ float bfhi(unsigned u) { return __builtin_bit_cast(float, u & 0xffff0000u); }
__device__ __forceinline__ unsigned pk4_fp8(float a, float b, float c, float d) { int v = __builtin_amdgcn_cvt_pk_fp8_f32(a, b, 0, false); v = __builtin_amdgcn_cvt_pk_fp8_f32(c, d, v, true); return (unsigned)v; }
__device__ __forceinline__ float wave_sum(float v) {
#pragma unroll
    for (int o = 1; o < 64; o <<= 1) v += __shfl_xor(v, o);
    return v;
}
__device__ __forceinline__ float wave_max(float v) {
#pragma unroll
    for (int o = 1; o < 64; o <<= 1) v = fmaxf(v, __shfl_xor(v, o));
    return v;
}
__device__ __forceinline__ float sigmoidf_(float x) { return 1.0f / (1.0f + __expf(-x)); }

#define XB_TMO      128
#define XB_XCNT(j)  (256  + 64 * (j))
#define XB_XSUB(j)  (1280 + 64 * (j))
#define XB_XGEN(j)  (2304 + 64 * (j))
#define XB_TOP      3328
#define XB_TOPGEN   3392
#define XCD_BAR_WORDS 3456
#define XB_SPIN_CAP (1u << 18)

__device__ __forceinline__ unsigned xb_ld(unsigned* p)              { return __hip_atomic_load(p, __ATOMIC_RELAXED, __HIP_MEMORY_SCOPE_AGENT); }
__device__ __forceinline__ unsigned xb_add(unsigned* p, unsigned v) { return __hip_atomic_fetch_add(p, v, __ATOMIC_RELAXED, __HIP_MEMORY_SCOPE_AGENT); }
__device__ __forceinline__ unsigned xb_xcc_id() { return (unsigned)__builtin_amdgcn_s_getreg((3 << 11) | 20) & 0xFu; }
#define XB_SPIN(cond, bar) do { unsigned _sp = 0; while (cond) { __builtin_amdgcn_s_sleep(1); \
    if ((++_sp & 255u) == 0u) { if (xb_ld(&(bar)[XB_TMO])) break; if (_sp > XB_SPIN_CAP) { atomicAdd(&(bar)[XB_TMO], 1u); break; } } } } while (0)

struct XcdBarrier {
    unsigned* bar; unsigned x;
    volatile LAS unsigned* st;
};

__device__ __forceinline__ XcdBarrier xcd_barrier_post(unsigned* bar, volatile LAS unsigned* st) {
    XcdBarrier b; b.bar = bar; b.x = xb_xcc_id(); b.st = st;
    if (threadIdx.x == 0) (void)xb_add(&bar[XB_XCNT(b.x)], 1u);
    return b;
}
__device__ __forceinline__ void xcd_barrier_complete(unsigned* bar, unsigned x, unsigned& nloc, unsigned& nx) {
    const unsigned G = gridDim.x * gridDim.y * gridDim.z;
    unsigned sum, cnt, mine, sp = 0u;
    for (;;) {
        sum = 0u; cnt = 0u; mine = 0u;
#pragma unroll
        for (unsigned j = 0; j < 16; ++j) { const unsigned c = xb_ld(&bar[XB_XCNT(j)]); sum += c; cnt += (c > 0u) ? 1u : 0u; mine = (j == x) ? c : mine; }
        if (sum == G) break;
        __builtin_amdgcn_s_sleep(1);
        if ((++sp & 255u) == 0u) { if (xb_ld(&bar[XB_TMO])) break; if (sp > XB_SPIN_CAP) { atomicAdd(&bar[XB_TMO], 1u); break; } }
    }
    nloc = mine > 0u ? mine : 1u; nx = cnt > 0u ? cnt : 1u;
}

__device__ __forceinline__ void xcd_barrier(const XcdBarrier& b) {
    asm volatile("s_waitcnt vmcnt(0)" ::: "memory");
    __syncthreads();
    if (threadIdx.x == 0) {
        unsigned* bar = b.bar;
        __builtin_amdgcn_s_waitcnt(0);
        unsigned nloc = b.st[0], nx = b.st[1];
        if (nloc == 0u) { xcd_barrier_complete(bar, b.x, nloc, nx); b.st[0] = nloc; b.st[1] = nx; }
        const unsigned old = xb_add(&bar[XB_XSUB(b.x)], 1u);
        const unsigned gen = old / nloc;
        if (old + 1u == (gen + 1u) * nloc) {
            __builtin_amdgcn_fence(__ATOMIC_RELEASE, "agent");
            asm volatile("s_waitcnt vmcnt(0)" ::: "memory");
            const unsigned og = xb_add(&bar[XB_TOP], 1u);
            const unsigned tg = og / nx;
            if (og + 1u == (tg + 1u) * nx) xb_add(&bar[XB_TOPGEN], 1u);
            else XB_SPIN(xb_ld(&bar[XB_TOPGEN]) == tg, bar);
            __builtin_amdgcn_fence(__ATOMIC_ACQUIRE, "agent");
            xb_add(&bar[XB_XGEN(b.x)], 1u);
            asm volatile("s_waitcnt vmcnt(0)" ::: "memory");
        } else {
            XB_SPIN(xb_ld(&bar[XB_XGEN(b.x)]) == gen, bar);
            __builtin_amdgcn_fence(__ATOMIC_ACQUIRE, "agent");
            asm volatile("s_waitcnt vmcnt(0)" ::: "memory");
        }
    }
    __syncthreads();
}

namespace pg8 {
__device__ __forceinline__ void row_rstd(const float* SS, int row0, int fq, float (&rs)[2][4]) {
#pragma unroll
    for (int ai = 0; ai < 2; ++ai)
#pragma unroll
        for (int m = 0; m < 4; ++m) { const f32x4* sp = (const f32x4*)(SS + (size_t)(row0 + ai * HALF + m * 16) * 64 + 16 * fq);
            const f32x4 a = sp[0], b = sp[1], c = sp[2], d = sp[3];
            float s = (((a[0] + a[1]) + (a[2] + a[3])) + ((b[0] + b[1]) + (b[2] + b[3]))) + (((c[0] + c[1]) + (c[2] + c[3])) + ((d[0] + d[1]) + (d[2] + d[3])));
            s += __shfl_xor(s, 16); s += __shfl_xor(s, 32);
            rs[ai][m] = 1.0f / sqrtf(s * (1.0f / 4096.0f) + 1e-6f); }
}
__device__ __forceinline__ float row_rstd1(const float* SS, int row, int fq) {
    const f32x4* sp = (const f32x4*)(SS + (size_t)row * 64 + 16 * fq);
    const f32x4 a = sp[0], b = sp[1], c = sp[2], d = sp[3];
    float s = (((a[0] + a[1]) + (a[2] + a[3])) + ((b[0] + b[1]) + (b[2] + b[3]))) + (((c[0] + c[1]) + (c[2] + c[3])) + ((d[0] + d[1]) + (d[2] + d[3])));
    s += __shfl_xor(s, 16); s += __shfl_xor(s, 32);
    return 1.0f / sqrtf(s * (1.0f / 4096.0f) + 1e-6f);
}
template <bool RSTD, bool P8> struct EpiProj {
    static constexpr bool PERM = true, AFTER_DRAIN = false, IDEMPOTENT = true;
    bf16_t* QKV; float* GATE; const float* cs; const PG8_LAS float* lr;
    __device__ __forceinline__ void operator()(const f32x4 (&acc)[2][2][4][2], const Unit& u, int wr, int wc, int fr, int fq) const {
        const int row0 = u.pm * BM + wr * 64 + fr;
        typedef unsigned u32x2 __attribute__((ext_vector_type(2)));
        const int pn_ = P8 ? P8MAP[u.pn] : P16MAP[u.pn];
        const bool gate = (pn_ == 46);
        const int hb0 = 2 * pn_; const bool rope0 = !gate && hb_is_rope(hb0), rope1 = !gate && hb_is_rope(hb0 + 1);
        const int e0 = 16 * wc + 4 * fq;
#pragma unroll
        for (int ai = 0; ai < 2; ++ai)
#pragma unroll
            for (int m = 0; m < 4; ++m) { const int row = row0 + ai * HALF + m * 16;
                const float rs = RSTD ? lr[u.idx * 256 + (row - u.pm * BM)] : 1.f;
                if (gate) { if (wc == 0) { float* gp = GATE + (size_t)row * 32 + 8 * fq; *(f32x4*)gp = acc[ai][0][m][0] * rs; *(f32x4*)(gp + 4) = acc[ai][0][m][1] * rs; } }
                else {
#pragma unroll
                    for (int bj = 0; bj < 2; ++bj) { bf16_t* base = QKV + (size_t)(hb0 + bj) * ((size_t)MROWS * HD) + (size_t)row * HD;
                        const f32x4 v0 = acc[ai][bj][m][0] * rs, v1 = acc[ai][bj][m][1] * rs;
                        if (bj == 0 ? rope0 : rope1) {
                            const f32x4 c = *(const f32x4*)(cs + (size_t)row * 64 + e0), s = *(const f32x4*)(cs + (size_t)MROWS * 64 + (size_t)row * 64 + e0);
                            const f32x4 o0 = v0 * c - v1 * s, o1 = v1 * c + v0 * s;
                            u32x2 w0, w1; w0.x = cvt_pk_bf16(o0[0], o0[1]); w0.y = cvt_pk_bf16(o0[2], o0[3]); w1.x = cvt_pk_bf16(o1[0], o1[1]); w1.y = cvt_pk_bf16(o1[2], o1[3]);
                            *(u32x2*)(base + e0) = w0; *(u32x2*)(base + e0 + 64) = w1;
                        } else {
                            u32x4 w; w.x = cvt_pk_bf16(v0[0], v0[1]); w.y = cvt_pk_bf16(v0[2], v0[3]); w.z = cvt_pk_bf16(v1[0], v1[1]); w.w = cvt_pk_bf16(v1[2], v1[3]);
                            *(u32x4*)(base + wc * 32 + 8 * fq) = w; } } }
                if (m & 1) asm volatile("" ::: "memory"); }
    }
};
template <bool SRC32, bool F8OUT> struct EpiResid {
    static constexpr bool PERM = true, AFTER_DRAIN = false, IDEMPOTENT = false;
    const void* src; bf16_t* dst; int ldc; unsigned char* XN8; float* SS;
    __device__ __forceinline__ void operator()(const f32x4 (&acc)[2][2][4][2], const Unit& u, int wr, int wc, int fr, int fq) const {
        const int row0 = u.pm * BM + wr * 64 + fr, col0 = u.pn * BM + wc * 32 + 8 * fq;
#pragma unroll
        for (int ai = 0; ai < 2; ++ai)
#pragma unroll
            for (int m = 0; m < 4; ++m) { const int row = row0 + ai * HALF + m * 16; const size_t off = (size_t)row * ldc + col0; float ss = 0.f;
#pragma unroll
                for (int bj = 0; bj < 2; ++bj) { f32x4 s0, s1;
                    if (SRC32) { const float* sp = (const float*)src + off + bj * HALF; s0 = *(const f32x4*)sp; s1 = *(const f32x4*)(sp + 4); }
                    else { const u32x4 sw = *(const u32x4*)((const bf16_t*)src + off + bj * HALF);
                        s0 = f32x4{__builtin_bit_cast(float, sw.x << 16), __builtin_bit_cast(float, sw.x & 0xffff0000u), __builtin_bit_cast(float, sw.y << 16), __builtin_bit_cast(float, sw.y & 0xffff0000u)};
                        s1 = f32x4{__builtin_bit_cast(float, sw.z << 16), __builtin_bit_cast(float, sw.z & 0xffff0000u), __builtin_bit_cast(float, sw.w << 16), __builtin_bit_cast(float, sw.w & 0xffff0000u)}; }
                    const f32x4 o0 = s0 + acc[ai][bj][m][0], o1 = s1 + acc[ai][bj][m][1];
                    u32x4 w; w.x = cvt_pk_bf16(o0[0], o0[1]); w.y = cvt_pk_bf16(o0[2], o0[3]); w.z = cvt_pk_bf16(o1[0], o1[1]); w.w = cvt_pk_bf16(o1[2], o1[3]);
                    *(u32x4*)(dst + off + bj * HALF) = w;
                    ss += ((o0[0] * o0[0] + o0[1] * o0[1]) + (o0[2] * o0[2] + o0[3] * o0[3])) + ((o1[0] * o1[0] + o1[1] * o1[1]) + (o1[2] * o1[2] + o1[3] * o1[3]));
                    if (F8OUT) { typedef unsigned u32x2 __attribute__((ext_vector_type(2))); u32x2 w8; w8.x = pk4_fp8(o0[0], o0[1], o0[2], o0[3]); w8.y = pk4_fp8(o1[0], o1[1], o1[2], o1[3]);
                        *(u32x2*)(XN8 + off + bj * HALF) = w8; } }
                ss += __shfl_xor(ss, 16); ss += __shfl_xor(ss, 32);
                if (fq == 0) SS[(size_t)row * 64 + u.pn * 4 + wc] = ss; }
    }
};
template <int ACT> struct EpiAct {
    static constexpr bool PERM = true, AFTER_DRAIN = false, IDEMPOTENT = true;
    bf16_t* O; int ldc; const PG8_LAS float* lr;
    __device__ __forceinline__ void operator()(const f32x4 (&acc)[2][2][4][2], const Unit& u, int wr, int wc, int fr, int fq) const {
        const int row0 = u.pm * BM + wr * 64 + fr, col0 = u.pn * BM + wc * 32 + 8 * fq;
        float rs[2][4];
        if (ACT == 2) {
#pragma unroll
            for (int ai = 0; ai < 2; ++ai)
#pragma unroll
                for (int m = 0; m < 4; ++m) rs[ai][m] = lr[u.idx * 256 + wr * 64 + fr + ai * HALF + m * 16]; }
#pragma unroll
        for (int ai = 0; ai < 2; ++ai)
#pragma unroll
            for (int m = 0; m < 4; ++m) { bf16_t* rowp = O + (size_t)(row0 + ai * HALF + m * 16) * ldc + col0;
#pragma unroll
                for (int bj = 0; bj < 2; ++bj) { f32x4 v0 = acc[ai][bj][m][0], v1 = acc[ai][bj][m][1];
                    if (ACT == 2) { const f32x4 z = {0.f, 0.f, 0.f, 0.f}; v0 = __builtin_elementwise_max(v0, z) * rs[ai][m]; v1 = __builtin_elementwise_max(v1, z) * rs[ai][m]; v0 = v0 * v0; v1 = v1 * v1; }
                    u32x4 w; w.x = cvt_pk_bf16(v0[0], v0[1]); w.y = cvt_pk_bf16(v0[2], v0[3]); w.z = cvt_pk_bf16(v1[0], v1[1]); w.w = cvt_pk_bf16(v1[2], v1[3]);
                    *(u32x4*)(rowp + bj * HALF) = w; } }
    }
};
template <bool NEXT> struct EpiPle {
    static constexpr bool PERM = true, AFTER_DRAIN = false, IDEMPOTENT = false;
    bf16_t* H; const bf16_t* PP; int ldc; const PG8_LAS float* lr; float* SSout; unsigned char* XN8;
    __device__ __forceinline__ void operator()(const f32x4 (&acc)[2][2][4][2], const Unit& u, int wr, int wc, int fr, int fq) const {
        const int row0 = u.pm * BM + wr * 64 + fr, col0 = u.pn * BM + wc * 32 + 8 * fq;
        float rs[2][4];
#pragma unroll
        for (int ai = 0; ai < 2; ++ai)
#pragma unroll
            for (int m = 0; m < 4; ++m) rs[ai][m] = lr[u.idx * 256 + wr * 64 + fr + ai * HALF + m * 16];
#pragma unroll
        for (int ai = 0; ai < 2; ++ai)
#pragma unroll
            for (int m = 0; m < 4; ++m) { const int row = row0 + ai * HALF + m * 16; const size_t off = (size_t)row * ldc + col0; float ss = 0.f;
#pragma unroll
                for (int bj = 0; bj < 2; ++bj) { const f32x4 v0 = acc[ai][bj][m][0] * rs[ai][m], v1 = acc[ai][bj][m][1] * rs[ai][m];
                    const u32x4 pw = *(const u32x4*)(PP + off + bj * HALF); const u32x4 hw = *(const u32x4*)(H + off + bj * HALF);
                    f32x4 p0 = {__builtin_bit_cast(float, pw.x << 16), __builtin_bit_cast(float, pw.x & 0xffff0000u), __builtin_bit_cast(float, pw.y << 16), __builtin_bit_cast(float, pw.y & 0xffff0000u)};
                    f32x4 p1 = {__builtin_bit_cast(float, pw.z << 16), __builtin_bit_cast(float, pw.z & 0xffff0000u), __builtin_bit_cast(float, pw.w << 16), __builtin_bit_cast(float, pw.w & 0xffff0000u)};
                    f32x4 h0 = {__builtin_bit_cast(float, hw.x << 16), __builtin_bit_cast(float, hw.x & 0xffff0000u), __builtin_bit_cast(float, hw.y << 16), __builtin_bit_cast(float, hw.y & 0xffff0000u)};
                    f32x4 h1 = {__builtin_bit_cast(float, hw.z << 16), __builtin_bit_cast(float, hw.z & 0xffff0000u), __builtin_bit_cast(float, hw.w << 16), __builtin_bit_cast(float, hw.w & 0xffff0000u)};
#pragma unroll
                    for (int i = 0; i < 4; ++i) { h0[i] += p0[i] * __builtin_amdgcn_rcpf(1.0f + __expf(-v0[i])); h1[i] += p1[i] * __builtin_amdgcn_rcpf(1.0f + __expf(-v1[i])); }
                    u32x4 w; w.x = cvt_pk_bf16(h0[0], h0[1]); w.y = cvt_pk_bf16(h0[2], h0[3]); w.z = cvt_pk_bf16(h1[0], h1[1]); w.w = cvt_pk_bf16(h1[2], h1[3]);
                    *(u32x4*)(H + off + bj * HALF) = w;
                    if (NEXT) { ss += ((h0[0] * h0[0] + h0[1] * h0[1]) + (h0[2] * h0[2] + h0[3] * h0[3])) + ((h1[0] * h1[0] + h1[1] * h1[1]) + (h1[2] * h1[2] + h1[3] * h1[3]));
                        typedef unsigned u32x2 __attribute__((ext_vector_type(2))); u32x2 w8; w8.x = pk4_fp8(h0[0], h0[1], h0[2], h0[3]); w8.y = pk4_fp8(h1[0], h1[1], h1[2], h1[3]); *(u32x2*)(XN8 + off + bj * HALF) = w8; } }
                if (NEXT) { ss += __shfl_xor(ss, 16); ss += __shfl_xor(ss, 32); if (fq == 0) SSout[(size_t)row * 64 + u.pn * 4 + wc] = ss; } }
    }
};
}

constexpr int PH_PER_LAYER = 7, NPH = 2 + 2 * PH_PER_LAYER;

constexpr int LRSTD_OFF = LDSCTL_OFF + 2048;
template <class Sched>
__device__ __forceinline__ void rstd_prepass(LAS unsigned char* lds, const Sched& S, const float* SS) {
    int tid_ = threadIdx.x; asm volatile("" : "+v"(tid_));
    const int tid = tid_, r = tid >> 1, half = tid & 1;
    LAS float* lr = (LAS float*)(lds + LRSTD_OFF);
    pg8::Unit u;
    for (int i = 0; i < 8 && S.next(i, u); ++i) {
        const f32x4* sp = (const f32x4*)(SS + (size_t)(u.pm * 256 + r) * 64 + 32 * half);
        f32x4 v[8];
#pragma unroll
        for (int k = 0; k < 8; ++k) v[k] = sp[k];
        float s = 0.f;
#pragma unroll
        for (int k = 0; k < 8; ++k) s += (v[k][0] + v[k][1]) + (v[k][2] + v[k][3]);
        s += __shfl_xor(s, 1);
        if (half == 0) lr[i * 256 + r] = 1.0f / sqrtf(s * (1.0f / 4096.0f) + 1e-6f);
    }
    __syncthreads();
}
struct Params { const void* in[20]; float* out; unsigned char* ws; int ph_lo, ph_hi; };
enum { I_X = 0, I_P, I_POS, I_NATT, I_WIN, I_FOXB, I_PEK, I_W1K, I_W2K, I_PEV, I_W1V, I_W2V, I_WO, I_NMLP, I_WUP, I_WDN, I_NPLE, I_WG, I_WPP, I_NFIN };

template <bool F32OUT, bool SRC16 = false>
__device__ __forceinline__ void norm_phase(const float* src, const float* g, void* dst, int gw, int NGW, int lane, unsigned char* dst8 = nullptr) {
    for (int row = gw; row < MROWS; row += NGW) {
        const f32x4* xr = (const f32x4*)(src + (size_t)row * DM) + lane;
        f32x4 v[16]; float ss = 0.f;
#pragma unroll
        for (int j = 0; j < 16; ++j) { if (SRC16) { const v2u hw = *((const v2u*)((const bf16*)src + (size_t)row * DM) + lane + 64 * j); v[j] = f32x4{bflo(hw.x), bfhi(hw.x), bflo(hw.y), bfhi(hw.y)}; } else v[j] = xr[64 * j]; ss += (v[j][0] * v[j][0] + v[j][1] * v[j][1]) + (v[j][2] * v[j][2] + v[j][3] * v[j][3]); }
        const float rstd = 1.0f / sqrtf(wave_sum(ss) * (1.0f / DM) + RMS_EPS);
#pragma unroll
        for (int j = 0; j < 16; ++j) { const f32x4 one = {1.f, 1.f, 1.f, 1.f}; const f32x4 gg = g ? *((const f32x4*)g + lane + 64 * j) : one; const f32x4 o = v[j] * rstd * gg;
            if (F32OUT) *((f32x4*)((float*)dst + (size_t)row * DM) + lane + 64 * j) = o;
            else { v2u w; w.x = pk2(o[0], o[1]); w.y = pk2(o[2], o[3]); *((v2u*)((bf16*)dst + (size_t)row * DM) + lane + 64 * j) = w;
                if (dst8) *((unsigned*)(dst8 + (size_t)row * DM) + lane + 64 * j) = pk4_fp8(o[0], o[1], o[2], o[3]); } }
    }
}

__device__ __forceinline__ int win_rowmap(int n) {
    int c;
    if (n < 2560) c = n; else if (n < 2584) c = 11776 + (n - 2560); else if (n < 5656) c = n - 24; else if (n < 5664) c = 11776 + 24 + (n - 5656); else c = n - 32;
    if (c < 11776) { const int hb = c >> 7; if (hb_is_rope(hb)) { const int d = c & 127, e = d & 63, nn = d >> 6; c = (hb << 7) + 32 * (e >> 4) + 8 * ((e >> 2) & 3) + 4 * nn + (e & 3); } }
    return c;
}
template <bool WINMAP, bool F8 = false>
__device__ __forceinline__ void p0_transpose_item(const float* W, int K, int N, bf16* WT, LAS float* scr, int item, int lane, const float* gk = nullptr) {
    const int nblk = N / 32, kb = item / nblk, nb = item % nblk, k0 = 64 * kb, n0 = 32 * nb;
#pragma unroll 8
    for (int i = 0; i < 32; ++i) { const int kk = 2 * i + (lane >> 5); scr[kk * 33 + (lane & 31)] = __builtin_nontemporal_load(W + (size_t)(k0 + kk) * N + n0 + (lane & 31)); }
    LDS_WAIT(); asm volatile("" ::: "memory");
    const int c = lane & 7;
    f32x4 ga = {1.f, 1.f, 1.f, 1.f}, gb = ga;
    if (gk) { ga = *(const f32x4*)(gk + k0 + 8 * c); gb = *(const f32x4*)(gk + k0 + 8 * c + 4); }
#pragma unroll
    for (int j = 0; j < 4; ++j) { const int n = (lane >> 3) + 8 * j; const LAS float* s = scr + (8 * c) * 33 + n;
        const float e0 = s[0 * 33] * ga[0], e1 = s[1 * 33] * ga[1], e2 = s[2 * 33] * ga[2], e3 = s[3 * 33] * ga[3], e4 = s[4 * 33] * gb[0], e5 = s[5 * 33] * gb[1], e6 = s[6 * 33] * gb[2], e7 = s[7 * 33] * gb[3];
        v4u o; o.x = pk2(e0, e1); o.y = pk2(e2, e3); o.z = pk2(e4, e5); o.w = pk2(e6, e7);
        const int nr = WINMAP ? win_rowmap(n0 + n) : (n0 + n);
        if (WINMAP) { const unsigned code = PTYPE[nr >> 8]; const size_t rr = (size_t)(((code & 127u) << 8) + (nr & 255));
            if (code & 128u) { v2u o8; o8.x = pk4_fp8(e0 * 64.f, e1 * 64.f, e2 * 64.f, e3 * 64.f); o8.y = pk4_fp8(e4 * 64.f, e5 * 64.f, e6 * 64.f, e7 * 64.f);
                __builtin_nontemporal_store(o8, (GAS v2u*)((unsigned char*)WT + W_IN8 + rr * K + k0 + 8 * c)); }
            else __builtin_nontemporal_store(o, (GAS v4u*)(WT + rr * K + k0 + 8 * c)); }
        else if (F8) { v2u o8; o8.x = pk4_fp8(e0 * 64.f, e1 * 64.f, e2 * 64.f, e3 * 64.f); o8.y = pk4_fp8(e4 * 64.f, e5 * 64.f, e6 * 64.f, e7 * 64.f);
            __builtin_nontemporal_store(o8, (GAS v2u*)((unsigned char*)WT + (size_t)nr * K + k0 + 8 * c)); }
        else __builtin_nontemporal_store(o, (GAS v4u*)(WT + (size_t)nr * K + k0 + 8 * c)); }
    LDS_WAIT(); asm volatile("" ::: "memory");
}

__device__ __forceinline__ void prologue_phase(const Params& P, LAS unsigned char* lds, int gw, int NGW, int wave, int lane, int rep = 0) {
    LAS float* scr = (LAS float*)(lds + RING_OFF + wave * 16384);
    unsigned char* ws = P.ws;
    constexpr int I_IN = (DM / 64) * (NIN / 32), I_O = (DM / 64) * (DM / 32), I_UP = (DM / 64) * (DFF / 32), I_DN = (DFF / 64) * (DM / 32), I_G = I_O, I_PPJ = (PLE / 64) * (DM / 32), I_C1 = (4096 / 64) * (256 / 32), I_C2 = (256 / 64) * (128 / 32);
    constexpr int PER_LAYER = I_IN + I_O + I_UP + I_DN + I_G + I_PPJ + 2 * I_C1 + 2 * I_C2;
    for (int it = gw; it < 2 * PER_LAYER; it += NGW) {
        const int l = it >= PER_LAYER ? 1 : 0; int r = it - l * PER_LAYER;
        unsigned char* wl = ws + WS_W + (size_t)l * LAYER_W;
        if (r < I_IN) { p0_transpose_item<true>((const float*)P.in[I_WIN] + (size_t)l * DM * NIN, DM, NIN, (bf16*)(wl + W_IN), scr, r, lane, (const float*)P.in[I_NATT] + (size_t)l * DM); continue; } r -= I_IN;
        if (r < I_O) { p0_transpose_item<false>((const float*)P.in[I_WO] + (size_t)l * DM * DM, DM, DM, (bf16*)(wl + W_O), scr, r, lane); continue; } r -= I_O;
        if (r < I_UP) { p0_transpose_item<false>((const float*)P.in[I_WUP] + (size_t)l * DM * DFF, DM, DFF, (bf16*)(wl + W_UP), scr, r, lane, (const float*)P.in[I_NMLP] + (size_t)l * DM); continue; } r -= I_UP;
        if (r < I_DN) { p0_transpose_item<false>((const float*)P.in[I_WDN] + (size_t)l * DFF * DM, DFF, DM, (bf16*)(wl + W_DN), scr, r, lane); continue; } r -= I_DN;
        if (r < I_G) { p0_transpose_item<false, true>((const float*)P.in[I_WG] + (size_t)l * DM * DM, DM, DM, (bf16*)(wl + W_G), scr, r, lane, (const float*)P.in[I_NPLE] + (size_t)l * DM); continue; } r -= I_G;
        if (r < I_PPJ) { p0_transpose_item<false>((const float*)P.in[I_WPP] + (size_t)l * PLE * DM, PLE, DM, (bf16*)(wl + W_PP), scr, r, lane); continue; } r -= I_PPJ;
        if (r < I_C1) { p0_transpose_item<false>((const float*)P.in[I_W1K] + (size_t)l * 4096 * 256, 4096, 256, (bf16*)(wl + W_C1K), scr, r, lane); continue; } r -= I_C1;
        if (r < I_C1) { p0_transpose_item<false>((const float*)P.in[I_W1V] + (size_t)l * 4096 * 256, 4096, 256, (bf16*)(wl + W_C1V), scr, r, lane); continue; } r -= I_C1;
        if (r < I_C2) { p0_transpose_item<false>((const float*)P.in[I_W2K] + (size_t)l * 256 * 128, 256, 128, (bf16*)(wl + W_C2K), scr, r, lane); continue; } r -= I_C2;
        p0_transpose_item<false>((const float*)P.in[I_W2V] + (size_t)l * 256 * 128, 256, 128, (bf16*)(wl + W_C2V), scr, r, lane);
    }
    if (gw < 256) {
        const int lkv = gw >> 6, kc = gw & 63, l = lkv >> 1, kv = lkv & 1;
        const float* pe = (const float*)P.in[kv ? I_PEV : I_PEK] + (size_t)l * 4096; const float* w1 = (const float*)P.in[kv ? I_W1V : I_W1K] + (size_t)l * 4096 * 256;
        f32x4 acc = {0.f, 0.f, 0.f, 0.f};
#pragma unroll 8
        for (int kk = 0; kk < 64; ++kk) { const int k = 64 * kc + kk; acc += pe[k] * *(const f32x4*)(w1 + (size_t)k * 256 + 4 * lane); }
        *(f32x4*)((float*)(ws + WS_CBP) + (size_t)(lkv * 64 + kc) * 256 + 4 * lane) = acc;
    }
    { const float* p = (const float*)P.in[I_P]; bf16* pb = (bf16*)(ws + WS_PB); const int n4 = DEPTH * MROWS * PLE / 4;
      for (int i = gw * 64 + lane; i < n4; i += NGW * 64) { const f32x4 v = *(const f32x4*)(p + (size_t)i * 4); v2u o; o.x = pk2(v[0], v[1]); o.y = pk2(v[2], v[3]); *(v2u*)(pb + (size_t)i * 4) = o; } }
    norm_phase<false>((const float*)P.in[I_X], nullptr, (bf16*)(ws + WS_XN), gw, NGW, lane, ws + WS_XN8);
    { const int* pos = (const int*)P.in[I_POS]; float* cs = (float*)(ws + WS_ROPE);
      for (int i = gw * 64 + lane; i < MROWS * 64; i += NGW * 64) { const int row = i >> 6, e = i & 63;
          const double inv = exp(-9.210340371976184 * (double)e / 64.0), a = (double)pos[row] * inv; double sn, cn; sincos(a, &sn, &cn);
          cs[i] = (float)cn; cs[(size_t)MROWS * 64 + i] = (float)sn; } }
}

__device__ __forceinline__ float gelu_tanh(float x) { const float u = 0.7978845608028654f * (x + 0.044715f * x * x * x); return 0.5f * x * (1.0f + tanhf(u)); }
__device__ __forceinline__ float log_sigmoid_f(float x) { return fminf(x, 0.f) - log1pf(expf(-fabsf(x))); }

__device__ __forceinline__ const bf16* head_ptr(const bf16* QKV, int hb, int b) { return QKV + (size_t)(hb * NB + b) * SEQ * HD; }
namespace fa {
typedef short bf16x8 __attribute__((ext_vector_type(8)));
typedef short s16x4 __attribute__((ext_vector_type(4)));
typedef float f32x16 __attribute__((ext_vector_type(16)));
typedef unsigned u32x4 __attribute__((ext_vector_type(4)));
constexpr int KVBLK = 64, SHM = 16384;
constexpr int L_V = 0, L_K = 2 * SHM, L_BIAS = 4 * SHM, L_WS = L_BIAS + 512, L_MISC = L_WS + 8 * 256, L_END = L_MISC + 256;
constexpr float SCALE = 0.08838834764831845f, C2 = 1.4426950408889634f * SCALE, THR = 8.f;
#define FA_KSWZ(row, colB) ((row) * 256 + ((colB) ^ (((row) & 7) << 4)))
#define FA_SBAR() __builtin_amdgcn_sched_barrier(0)
__device__ __forceinline__ int v_st(int k, int c) { const int kk = (k & ~0xC) | ((k & 4) << 1) | ((k & 8) >> 1); return ((kk >> 3) * 4 + (c >> 5)) * 512 + ((kk & 7) * 32 + (c & 31)) * 2; }
__device__ __forceinline__ int v_rd_base(int lane) { return ((lane & 3) << 3) | (((lane >> 2) & 3) << 6) | (((lane >> 4) & 1) << 5) | (((lane >> 5) & 1) << 8); }
constexpr int v_rd_off(int d0, int ks, int half) { return d0 * 512 + ks * 4096 + half * 2048; }
__device__ __forceinline__ int crow(int r, int hi) { return (r & 3) + 8 * (r >> 2) + 4 * hi; }
__device__ __forceinline__ unsigned cvtpk(float lo, float hi) { unsigned r; asm volatile("v_cvt_pk_bf16_f32 %0, %1, %2" : "=v"(r) : "v"(lo), "v"(hi)); return r; }

__device__ __forceinline__ void mask_tile(f32x16& p0, f32x16& p1, int dq, unsigned W) {
    const float NEG = -__builtin_inff();
#pragma unroll
    for (int r = 0; r < 16; ++r) { const int c = (r & 3) + 8 * (r >> 2);
        if ((unsigned)(dq - c) >= W) p0[r] = NEG;
        if ((unsigned)(dq - c - 32) >= W) p1[r] = NEG; }
}
__device__ __forceinline__ void partialSM(f32x16& p0, f32x16& p1, float& m_reg, float& mn, float& alpha) {
    float pmax = p0[0];
#pragma unroll
    for (int r = 1; r < 16; ++r) pmax = fmaxf(pmax, p0[r]);
#pragma unroll
    for (int r = 0; r < 16; ++r) pmax = fmaxf(pmax, p1[r]);
    { auto rr = __builtin_amdgcn_permlane32_swap(__float_as_uint(pmax), __float_as_uint(pmax), false, false);
      pmax = fmaxf(__uint_as_float(rr[0]), __uint_as_float(rr[1])); }
    if (__builtin_expect(__all((pmax - m_reg) * SCALE <= THR), 1)) { mn = m_reg; alpha = 1.f; }
    else { mn = fmaxf(m_reg, pmax); alpha = __builtin_amdgcn_exp2f((m_reg - mn) * C2); m_reg = mn; }
    const float mnL = -mn * C2;
#pragma unroll
    for (int r = 0; r < 16; ++r) p0[r] = __builtin_amdgcn_exp2f(fmaf(p0[r], C2, mnL));
#pragma unroll
    for (int r = 0; r < 16; ++r) p1[r] = __builtin_amdgcn_exp2f(fmaf(p1[r], C2, mnL));
}
#define FA_PK4(P, B_, OUT) do { unsigned a0 = cvtpk(P[B_+0], P[B_+1]), a1 = cvtpk(P[B_+2], P[B_+3]); unsigned b0 = cvtpk(P[B_+4], P[B_+5]), b1 = cvtpk(P[B_+6], P[B_+7]); \
        auto r0 = __builtin_amdgcn_permlane32_swap(a0, b0, false, false); auto r1 = __builtin_amdgcn_permlane32_swap(a1, b1, false, false); \
        u32x4 w = {r0[0], r1[0], r0[1], r1[1]}; OUT = __builtin_bit_cast(bf16x8, w); } while (0)
__device__ __forceinline__ void finishSM(f32x16& p0, f32x16& p1, float alpha, float& l_reg, bf16x8& pa0, bf16x8& pa1, bf16x8& pa2, bf16x8& pa3) {
    float ps = 0;
#pragma unroll
    for (int r = 0; r < 16; ++r) ps += p0[r];
#pragma unroll
    for (int r = 0; r < 16; ++r) ps += p1[r];
    { auto rr = __builtin_amdgcn_permlane32_swap(__float_as_uint(ps), __float_as_uint(ps), false, false); ps = __uint_as_float(rr[0]) + __uint_as_float(rr[1]); }
    l_reg = l_reg * alpha + ps;
    FA_PK4(p0, 0, pa0); FA_PK4(p0, 8, pa1); FA_PK4(p1, 0, pa2); FA_PK4(p1, 8, pa3);
}
template <int KB>
__device__ __forceinline__ void qkt(f32x16& p0, f32x16& p1, const LAS char* lds, int r32, int hi, const bf16x8* qr) {
    p0 = f32x16{}; p1 = f32x16{};
    const LAS char* kb[4];
#pragma unroll
    for (int dd = 0; dd < 4; ++dd) kb[dd] = lds + L_K + KB * SHM + FA_KSWZ(r32, (dd * 16 + hi * 8) * 2);
#pragma unroll
    for (int d0 = 0; d0 < 8; ++d0) { const LAS char* a = kb[d0 & 3] + (d0 >> 2) * 128;
        const bf16x8 b0 = *(const LAS bf16x8*)a, b1 = *(const LAS bf16x8*)(a + 32 * 256);
        p0 = __builtin_amdgcn_mfma_f32_32x32x16_bf16(b0, qr[d0], p0, 0, 0, 0);
        p1 = __builtin_amdgcn_mfma_f32_32x32x16_bf16(b1, qr[d0], p1, 0, 0, 0); }
}
template <int VB>
__device__ __forceinline__ void pv_tile(f32x16* o, int vb0, bf16x8 pa0, bf16x8 pa1, bf16x8 pa2, bf16x8 pa3) {
#define FA_TRRD(dst, off) asm volatile("ds_read_b64_tr_b16 %0, %1 offset:%2" : "=&v"(dst) : "v"(vb0), "i"(off) : "memory")
#define FA_PV_D0(d0) do { s16x4 l0, l1, l2, l3, h0, h1, h2, h3; constexpr int b_ = L_V + VB * SHM + v_rd_off(d0, 0, 0); \
        FA_TRRD(l0, b_); FA_TRRD(h0, b_ + 2048); FA_TRRD(l1, b_ + 4096); FA_TRRD(h1, b_ + 6144); FA_TRRD(l2, b_ + 8192); FA_TRRD(h2, b_ + 10240); FA_TRRD(l3, b_ + 12288); FA_TRRD(h3, b_ + 14336); \
        asm volatile("s_waitcnt lgkmcnt(0)" ::: "memory"); FA_SBAR(); \
        o[d0] = __builtin_amdgcn_mfma_f32_32x32x16_bf16(pa0, (bf16x8){l0[0], l0[1], l0[2], l0[3], h0[0], h0[1], h0[2], h0[3]}, o[d0], 0, 0, 0); \
        o[d0] = __builtin_amdgcn_mfma_f32_32x32x16_bf16(pa1, (bf16x8){l1[0], l1[1], l1[2], l1[3], h1[0], h1[1], h1[2], h1[3]}, o[d0], 0, 0, 0); \
        o[d0] = __builtin_amdgcn_mfma_f32_32x32x16_bf16(pa2, (bf16x8){l2[0], l2[1], l2[2], l2[3], h2[0], h2[1], h2[2], h2[3]}, o[d0], 0, 0, 0); \
        o[d0] = __builtin_amdgcn_mfma_f32_32x32x16_bf16(pa3, (bf16x8){l3[0], l3[1], l3[2], l3[3], h3[0], h3[1], h3[2], h3[3]}, o[d0], 0, 0, 0); } while (0)
    FA_PV_D0(0); FA_PV_D0(1); FA_PV_D0(2); FA_PV_D0(3);
#undef FA_PV_D0
#undef FA_TRRD
}

struct Blk {
    const bf16* Q; int qstride;
    const bf16* K; const bf16* V; int kvstride;
    int qpos;
    int j_lo, j_hi;
};
struct Extra { const float* cum; float cref; unsigned mlo, mhi; int W; };

struct Stage { bf16x8 k0, k1, v0, v1; f32x4 cb; };
template <int MODE>
__device__ __forceinline__ void stage_load(Stage& S, const Blk& B, const Extra& X, int j, int sr, int sc, int tid) {
    const size_t r0 = (size_t)(j * KVBLK + sr) * B.kvstride + sc, r1 = r0 + (size_t)32 * B.kvstride;
    S.v0 = *(const bf16x8*)(B.V + r0); S.v1 = *(const bf16x8*)(B.V + r1);
    S.k0 = *(const bf16x8*)(B.K + r0); S.k1 = *(const bf16x8*)(B.K + r1);
    if (MODE == 0) { if (tid < 16) S.cb = *(const f32x4*)(X.cum + j * KVBLK + tid * 4); }
}
template <int MODE>
__device__ __forceinline__ void stage_write(const Stage& S, LAS char* lds, int buf, int kws, int vst0, int vst1, float cref, int tid) {
    *(LAS bf16x8*)(lds + L_V + buf * SHM + vst0) = S.v0; *(LAS bf16x8*)(lds + L_V + buf * SHM + vst1) = S.v1;
    *(LAS bf16x8*)(lds + L_K + buf * SHM + kws) = S.k0; *(LAS bf16x8*)(lds + L_K + buf * SHM + kws + 32 * 256) = S.k1;
    if (MODE == 0) { if (tid < 16) { const float is = 11.313708498984761f; f32x4 b = {(cref - S.cb[0]) * is, (cref - S.cb[1]) * is, (cref - S.cb[2]) * is, (cref - S.cb[3]) * is};
        *(LAS f32x4*)(lds + L_BIAS + buf * 256 + tid * 16) = b; } }
}

template <int MODE>
__device__ __forceinline__ void softmax_block(LAS char* lds, const Blk& B, const Extra& X, f32x16 (&o)[4], float& m_reg, float& l_reg) {
    int tid_ = threadIdx.x; asm volatile("" : "+v"(tid_));
    const int tid = tid_, wid = __builtin_amdgcn_readfirstlane(tid >> 6), lane = tid & 63, r32 = lane & 31, hi = lane >> 5;
    const int sr = tid >> 4, sc = (tid & 15) * 8, kws = FA_KSWZ(sr, sc * 2), vst0 = v_st(sr, sc), vst1 = v_st(32 + sr, sc);
    const int vb0 = (int)(unsigned)(size_t)(lds) + v_rd_base(lane);
    LAS float* al_l = (LAS float*)(lds + L_WS + wid * 256);
    const int W = (MODE == 2) ? X.W : (1 << 30);
    const int qlo = B.qpos, qm = qlo + r32 - 4 * hi;
    bf16x8 qr[8];
#pragma unroll
    for (int d0 = 0; d0 < 8; ++d0) qr[d0] = *(const bf16x8*)(B.Q + (size_t)r32 * B.qstride + d0 * 16 + hi * 8);
#pragma unroll
    for (int d = 0; d < 4; ++d) o[d] = f32x16{};
    m_reg = -1e30f; l_reg = 0.f;
    const int NT = B.j_hi - B.j_lo;
    Stage S;
    stage_load<MODE>(S, B, X, B.j_lo, sr, sc, tid);
    asm volatile("s_waitcnt vmcnt(0)" ::: "memory");
    stage_write<MODE>(S, lds, 0, kws, vst0, vst1, X.cref, tid);
    __syncthreads();
    f32x16 p0, p1; float mn, alpha; bf16x8 pa0, pa1, pa2, pa3;
#define FA_STEP(t, BUF) do { const int j_ = B.j_lo + (t), kb_ = j_ * KVBLK; \
        if ((t) + 1 < NT) stage_load<MODE>(S, B, X, j_ + 1, sr, sc, tid); \
        const bool act_ = (kb_ <= qlo + 31) && (kb_ + KVBLK - 1 >= qlo - W + 1); \
        if (act_) { \
            FA_SBAR(); qkt<BUF>(p0, p1, lds, r32, hi, qr); \
            if (MODE == 0) { const LAS f32x4* bp = (const LAS f32x4*)(lds + L_BIAS + BUF * 256) + hi; \
                _Pragma("unroll") for (int g_ = 0; g_ < 4; ++g_) { const f32x4 b0 = bp[2 * g_], b1 = bp[8 + 2 * g_]; \
                    _Pragma("unroll") for (int i_ = 0; i_ < 4; ++i_) { p0[4 * g_ + i_] += b0[i_]; p1[4 * g_ + i_] += b1[i_]; } } } \
            if (MODE == 1) { const bool sel_ = ((j_ < 32 ? (X.mlo >> j_) : (X.mhi >> (j_ - 32))) & 1u) != 0u; \
                if (!sel_) { const float NEG_ = -__builtin_inff(); _Pragma("unroll") for (int r = 0; r < 16; ++r) { p0[r] = NEG_; p1[r] = NEG_; } } } \
            if (kb_ + KVBLK - 1 > qlo || kb_ <= qlo + 31 - W) mask_tile(p0, p1, qm - kb_, (unsigned)W); \
            partialSM(p0, p1, m_reg, mn, alpha); \
            if (__any(alpha < 1.f)) { if (hi == 0) al_l[r32] = alpha; asm volatile("s_waitcnt lgkmcnt(0)" ::: "memory"); \
                _Pragma("unroll") for (int r = 0; r < 16; ++r) { const float a_ = al_l[crow(r, hi)]; _Pragma("unroll") for (int d_ = 0; d_ < 4; ++d_) o[d_][r] *= a_; } } \
            finishSM(p0, p1, alpha, l_reg, pa0, pa1, pa2, pa3); FA_SBAR(); \
            pv_tile<BUF>(o, vb0, pa0, pa1, pa2, pa3); } \
        if ((t) + 1 < NT) { asm volatile("s_waitcnt vmcnt(0)" ::: "memory"); stage_write<MODE>(S, lds, (BUF) ^ 1, kws, vst0, vst1, X.cref, tid); } \
        __syncthreads(); } while (0)
    for (int t = 0; t < NT; t += 2) { FA_STEP(t, 0); if (t + 1 < NT) FA_STEP(t + 1, 1); }
#undef FA_STEP
}

__device__ __forceinline__ float swap32(float v, int hi) {
    auto rr = __builtin_amdgcn_permlane32_swap(__float_as_uint(v), __float_as_uint(v), false, false);
    return __uint_as_float(hi ? rr[0] : rr[1]);
}
__device__ __forceinline__ void sb_weights(f32x16& p0, f32x16& p1, float& carry, int dq, bool needmask, int hi) {
    f32x16 l0, l1;
#pragma unroll
    for (int r = 0; r < 16; ++r) { const int c = (r & 3) + 8 * (r >> 2);
        { const float z = p0[r] * C2; const float sp = fmaxf(z, 0.f) + __builtin_amdgcn_logf(1.f + __builtin_amdgcn_exp2f(-fabsf(z))); const bool v = !needmask || (dq - c > 0); p0[r] = v ? z : -__builtin_inff(); l0[r] = v ? -sp : 0.f; }
        { const float z = p1[r] * C2; const float sp = fmaxf(z, 0.f) + __builtin_amdgcn_logf(1.f + __builtin_amdgcn_exp2f(-fabsf(z))); const bool v = !needmask || (dq - c - 32 > 0); p1[r] = v ? z : -__builtin_inff(); l1[r] = v ? -sp : 0.f; } }
    float T[8];
#pragma unroll
    for (int g = 0; g < 4; ++g) { l0[4 * g + 2] += l0[4 * g + 3]; l0[4 * g + 1] += l0[4 * g + 2]; l0[4 * g] += l0[4 * g + 1]; T[g] = l0[4 * g];
                                  l1[4 * g + 2] += l1[4 * g + 3]; l1[4 * g + 1] += l1[4 * g + 2]; l1[4 * g] += l1[4 * g + 1]; T[4 + g] = l1[4 * g]; }
    float ex[8], send[8]; float run = 0.f;
#pragma unroll
    for (int k = 7; k >= 0; --k) { ex[k] = run; run += T[k]; send[k] = hi ? run : ex[k]; }
    const float tot_all = run + swap32(run, hi);
#pragma unroll
    for (int k = 0; k < 8; ++k) { const float off = ex[k] + swap32(send[k], hi) + carry;
#pragma unroll
        for (int i = 0; i < 4; ++i) { if (k < 4) l0[4 * k + i] += off; else l1[4 * (k - 4) + i] += off; } }
#pragma unroll
    for (int r = 0; r < 16; ++r) { p0[r] = __builtin_amdgcn_exp2f(p0[r] + l0[r]); p1[r] = __builtin_amdgcn_exp2f(p1[r] + l1[r]); }
    carry += tot_all;
}
__device__ __forceinline__ void sb_block(LAS char* lds, const Blk& B, f32x16 (&o)[4]) {
    int tid_ = threadIdx.x; asm volatile("" : "+v"(tid_));
    const int tid = tid_, wid = __builtin_amdgcn_readfirstlane(tid >> 6), lane = tid & 63, r32 = lane & 31, hi = lane >> 5;
    const int sr = tid >> 4, sc = (tid & 15) * 8, kws = FA_KSWZ(sr, sc * 2), vst0 = v_st(sr, sc), vst1 = v_st(32 + sr, sc);
    const int vb0 = (int)(unsigned)(size_t)(lds) + v_rd_base(lane);
    volatile LAS unsigned* dflag = (volatile LAS unsigned*)(lds + L_MISC + 64);
    const int qlo = B.qpos, qm = qlo + r32 - 4 * hi;
    bf16x8 qr[8];
#pragma unroll
    for (int d0 = 0; d0 < 8; ++d0) qr[d0] = *(const bf16x8*)(B.Q + (size_t)r32 * B.qstride + d0 * 16 + hi * 8);
#pragma unroll
    for (int d = 0; d < 4; ++d) o[d] = f32x16{};
    float carry = 0.f; bool wdone = false;
    const int NT = B.j_hi - B.j_lo;
    Stage S; Extra X{};
    if (lane == 0) { dflag[wid] = 0u; dflag[8 + wid] = 0u; }
    stage_load<3>(S, B, X, B.j_hi - 1, sr, sc, tid);
    asm volatile("s_waitcnt vmcnt(0)" ::: "memory");
    stage_write<3>(S, lds, 0, kws, vst0, vst1, 0.f, tid);
    __syncthreads();
    f32x16 p0, p1; bf16x8 pa0, pa1, pa2, pa3;
#define FA_SBSTEP(t, BUF) do { const int j_ = B.j_hi - 1 - (t), kb_ = j_ * KVBLK; \
        if ((t) + 1 < NT) stage_load<3>(S, B, X, j_ - 1, sr, sc, tid); \
        const bool act_ = !wdone && (kb_ < qlo + 31); \
        if (act_) { \
            FA_SBAR(); qkt<BUF>(p0, p1, lds, r32, hi, qr); \
            sb_weights(p0, p1, carry, qm - kb_, kb_ + KVBLK - 1 >= qlo, hi); \
            FA_PK4(p0, 0, pa0); FA_PK4(p0, 8, pa1); FA_PK4(p1, 0, pa2); FA_PK4(p1, 8, pa3); FA_SBAR(); \
            pv_tile<BUF>(o, vb0, pa0, pa1, pa2, pa3); \
            wdone = __all(carry < -160.f); } \
        if (lane == 0) dflag[((t) & 1) * 8 + wid] = (wdone || kb_ == 0) ? 1u : 0u; \
        if ((t) + 1 < NT) { asm volatile("s_waitcnt vmcnt(0)" ::: "memory"); stage_write<3>(S, lds, (BUF) ^ 1, kws, vst0, vst1, 0.f, tid); } \
        __syncthreads(); \
        { unsigned all_ = 1u; _Pragma("unroll") for (int w_ = 0; w_ < 8; ++w_) all_ &= dflag[((t) & 1) * 8 + w_]; stop = all_ != 0u; } } while (0)
    bool stop = false;
    for (int t = 0; t < NT; t += 2) { FA_SBSTEP(t, 0); if (stop) break; if (t + 1 < NT) { FA_SBSTEP(t + 1, 1); if (stop) break; } }
#undef FA_SBSTEP
    __syncthreads();
}

__device__ __forceinline__ void row_scales(LAS char* lds, int wid, int r32, int hi, float rs, float (&sc)[16]) {
    LAS float* li_l = (LAS float*)(lds + L_WS + wid * 256) + 32;
    if (hi == 0) li_l[r32] = rs;
    asm volatile("s_waitcnt lgkmcnt(0)" ::: "memory");
#pragma unroll
    for (int r = 0; r < 16; ++r) sc[r] = li_l[crow(r, hi)];
    asm volatile("s_waitcnt lgkmcnt(0)" ::: "memory");
}
__device__ __forceinline__ void store_bf16(const f32x16 (&o)[4], const float (&sc)[16], bf16* dst, size_t ld, int r32, int hi) {
#pragma unroll
    for (int r = 0; r < 16; ++r) { const int orow = crow(r, hi);
#pragma unroll
        for (int d0 = 0; d0 < 4; ++d0) { const float v = o[d0][r] * sc[r]; const float vn = __shfl_xor(v, 1);
            if ((r32 & 1) == 0) *(unsigned*)(dst + (size_t)orow * ld + d0 * 32 + r32) = cvtpk(v, vn); } }
}
}

__device__ __forceinline__ void nsa_block(const Params& P, LAS char* lds, int b, int g, int qb) {
    unsigned char* ws = P.ws;
    const bf16* QKV = (const bf16*)(ws + WS_QKV);
    const float* GATE = (const float*)(ws + WS_GATE);
    int tid_ = threadIdx.x; asm volatile("" : "+v"(tid_));
    const int tid = tid_, wid = __builtin_amdgcn_readfirstlane(tid >> 6), lane = tid & 63, r32 = lane & 31, hi = lane >> 5;
    const int hh = wid & 3, tb = wid >> 2, h = 4 * g + hh, P0 = 64 * qb + 32 * tb, row0 = b * SEQ + P0;
    fa::Blk B; B.Q = head_ptr(QKV, HB_QA + h, b) + (size_t)P0 * HD; B.qstride = HD; B.kvstride = HD; B.qpos = P0;
    fa::f32x16 o[4]; float m_reg, l_reg; float sc[16];
    const float* oc = (const float*)(ws + WS_OCMP) + (size_t)row0 * 1024 + h * 128;
    float* os = (float*)(ws + WS_OS) + (size_t)row0 * 1024 + h * 128;
    {
        B.K = head_ptr(QKV, HB_KS + g, b); B.V = head_ptr(QKV, HB_VS + g, b); B.j_lo = 0; B.j_hi = qb + 1;
        const unsigned long long m = ((const unsigned long long*)(ws + WS_SEL))[(size_t)(b * 2 + g) * SEQ + P0 + r32];
        fa::Extra X{}; X.mlo = (unsigned)m; X.mhi = (unsigned)(m >> 32);
        fa::softmax_block<1>(lds, B, X, o, m_reg, l_reg);
        const float g1 = sigmoidf_(GATE[(size_t)(row0 + r32) * 32 + 3 * h + 1]);
        fa::row_scales(lds, wid, r32, hi, g1 / l_reg, sc);
#pragma unroll
        for (int r = 0; r < 16; ++r) { const int orow = fa::crow(r, hi);
#pragma unroll
            for (int d0 = 0; d0 < 4; ++d0) { const size_t off = (size_t)orow * 1024 + d0 * 32 + r32; os[off] = oc[off] + o[d0][r] * sc[r]; } }
    }
    {
        B.K = head_ptr(QKV, HB_KW + g, b); B.V = head_ptr(QKV, HB_VW + g, b); B.j_lo = qb >= 8 ? qb - 8 : 0; B.j_hi = qb + 1;
        fa::Extra X{}; X.W = 512;
        fa::softmax_block<2>(lds, B, X, o, m_reg, l_reg);
        const float g2 = sigmoidf_(GATE[(size_t)(row0 + r32) * 32 + 3 * h + 2]);
        fa::row_scales(lds, wid, r32, hi, g2 / l_reg, sc);
        asm volatile("s_waitcnt vmcnt(0)" ::: "memory"); __builtin_amdgcn_fence(__ATOMIC_ACQUIRE, "agent"); asm volatile("s_waitcnt vmcnt(0)" ::: "memory");
        bf16* mx = (bf16*)(ws + WS_MIX) + (size_t)row0 * DM + h * 128;
#pragma unroll
        for (int r = 0; r < 16; ++r) { const int orow = fa::crow(r, hi);
#pragma unroll
            for (int d0 = 0; d0 < 4; ++d0) { const float v = os[(size_t)orow * 1024 + d0 * 32 + r32] + o[d0][r] * sc[r]; const float vn = __shfl_xor(v, 1);
                if ((r32 & 1) == 0) *(unsigned*)(mx + (size_t)orow * DM + d0 * 32 + r32) = fa::cvtpk(v, vn); } }
    }
}
__device__ __forceinline__ void fox_block(const Params& P, LAS char* lds, int b, int h, int x) {
    unsigned char* ws = P.ws;
    const bf16* QKV = (const bf16*)(ws + WS_QKV);
    int tid_ = threadIdx.x; asm volatile("" : "+v"(tid_));
    const int tid = tid_, wid = __builtin_amdgcn_readfirstlane(tid >> 6), lane = tid & 63, r32 = lane & 31, hi = lane >> 5;
    const int P0 = 256 * x + 32 * wid, row0 = b * SEQ + P0;
    fa::Blk B; B.Q = head_ptr(QKV, HB_QB + h, b) + (size_t)P0 * HD; B.qstride = HD; B.kvstride = HD; B.qpos = P0;
    B.K = head_ptr(QKV, HB_KB + h, b); B.V = head_ptr(QKV, HB_VB + h, b); B.j_lo = 0; B.j_hi = 4 * x + 4;
    fa::Extra X{}; X.cum = (const float*)(ws + WS_CUM) + (size_t)(b * 8 + h) * SEQ; X.cref = X.cum[256 * x];
    fa::f32x16 o[4]; float m_reg, l_reg; float sc[16];
    fa::softmax_block<0>(lds, B, X, o, m_reg, l_reg);
    fa::row_scales(lds, wid, r32, hi, 1.0f / l_reg, sc);
    fa::store_bf16(o, sc, (bf16*)(ws + WS_MIX) + (size_t)row0 * DM + 1024 + h * 128, DM, r32, hi);
}
__device__ __forceinline__ void sbk_block(const Params& P, LAS char* lds, int b, int h, int x) {
    unsigned char* ws = P.ws;
    const bf16* QKV = (const bf16*)(ws + WS_QKV);
    int tid_ = threadIdx.x; asm volatile("" : "+v"(tid_));
    const int tid = tid_, wid = __builtin_amdgcn_readfirstlane(tid >> 6), lane = tid & 63, r32 = lane & 31, hi = lane >> 5;
    const int P0 = 256 * x + 32 * wid, row0 = b * SEQ + P0;
    fa::Blk B; B.Q = head_ptr(QKV, HB_QD + h, b) + (size_t)P0 * HD; B.qstride = HD; B.kvstride = HD; B.qpos = P0;
    B.K = head_ptr(QKV, HB_KD + h, b); B.V = head_ptr(QKV, HB_VD + h, b); B.j_lo = 0; B.j_hi = 4 * x + 4;
    fa::f32x16 o[4]; float sc[16];
    fa::sb_block(lds, B, o);
#pragma unroll
    for (int r = 0; r < 16; ++r) sc[r] = 1.f;
    fa::store_bf16(o, sc, (bf16*)(ws + WS_MIX) + (size_t)row0 * DM + 3072 + h * 128, DM, r32, hi);
}
constexpr int YQ_DIL = 3 * 16 * 16;
__device__ __forceinline__ void dil_block(const Params& P, LAS char* lds, int cfg, int b, int h, int blk) {
    unsigned char* ws = P.ws;
    const bf16* QKV = (const bf16*)(ws + WS_QKV);
    int tid_ = threadIdx.x; asm volatile("" : "+v"(tid_));
    const int tid = tid_, wid = __builtin_amdgcn_readfirstlane(tid >> 6), lane = tid & 63, r32 = lane & 31, hi = lane >> 5;
    const int d = cfg == 0 ? 1 : (cfg == 1 ? 4 : 16), nb = 16 / d, res = blk / nb, xb = blk % nb, U0 = 256 * xb + 32 * wid;
    fa::Blk B; B.Q = head_ptr(QKV, HB_QC + h, b) + (size_t)(res + d * U0) * HD; B.qstride = d * HD; B.kvstride = d * HD; B.qpos = U0;
    B.K = head_ptr(QKV, HB_KCC + h, b) + (size_t)res * HD; B.V = head_ptr(QKV, HB_VCC + h, b) + (size_t)res * HD; B.j_lo = xb ? 4 * xb - 2 : 0; B.j_hi = 4 * xb + 4;
    fa::Extra X{}; X.W = 129;
    fa::f32x16 o[4]; float m_reg, l_reg; float sc[16];
    fa::softmax_block<2>(lds, B, X, o, m_reg, l_reg);
    fa::row_scales(lds, wid, r32, hi, 1.0f / l_reg, sc);
    float* dout = (float*)(ws + WS_DO) + (size_t)cfg * MROWS * 1024 + (size_t)(b * SEQ + res + d * U0) * 1024 + h * 128;
#pragma unroll
    for (int r = 0; r < 16; ++r) { const int orow = fa::crow(r, hi);
#pragma unroll
        for (int d0 = 0; d0 < 4; ++d0) dout[(size_t)orow * d * 1024 + d0 * 32 + r32] = o[d0][r] * sc[r]; }
    if (hi == 0) ((float*)(ws + WS_LSE))[(size_t)cfg * MROWS * 8 + (size_t)(b * SEQ + res + d * (U0 + r32)) * 8 + h] = m_reg * fa::SCALE + logf(l_reg);
}
__device__ __forceinline__ void phaseZ_dil_combine(const Params& P, int gw, int NGW, int lane) {
    unsigned char* ws = P.ws;
    const float* DO = (const float*)(ws + WS_DO); const float* LSE = (const float*)(ws + WS_LSE);
    bf16* MIX = (bf16*)(ws + WS_MIX);
    const int h = lane >> 3, c0 = (lane & 7) * 16;
    for (int row = gw; row < MROWS; row += NGW) {
        const float l0 = LSE[(size_t)row * 8 + h], l1 = LSE[(size_t)MROWS * 8 + (size_t)row * 8 + h], l2 = LSE[(size_t)2 * MROWS * 8 + (size_t)row * 8 + h];
        const float mx = fmaxf(l0, fmaxf(l1, l2)); float w0 = __expf(l0 - mx), w1 = __expf(l1 - mx), w2 = __expf(l2 - mx); const float inv = 1.0f / (w0 + w1 + w2); w0 *= inv; w1 *= inv; w2 *= inv;
        const float* p0 = DO + (size_t)row * 1024 + h * 128 + c0; const float* p1 = p0 + (size_t)MROWS * 1024; const float* p2 = p1 + (size_t)MROWS * 1024;
        bf16* dst = MIX + (size_t)row * DM + 2048 + h * 128 + c0;
#pragma unroll
        for (int q = 0; q < 2; ++q) { const f32x4 a0 = *(const f32x4*)(p0 + 8 * q), a1 = *(const f32x4*)(p0 + 8 * q + 4), b0 = *(const f32x4*)(p1 + 8 * q), b1 = *(const f32x4*)(p1 + 8 * q + 4), c0v = *(const f32x4*)(p2 + 8 * q), c1v = *(const f32x4*)(p2 + 8 * q + 4);
            const f32x4 o0 = a0 * w0 + b0 * w1 + c0v * w2, o1 = a1 * w0 + b1 * w1 + c1v * w2;
            v4u w; w.x = pk2(o0[0], o0[1]); w.y = pk2(o0[2], o0[3]); w.z = pk2(o1[0], o1[1]); w.w = pk2(o1[2], o1[3]);
            *(v4u*)(dst + 8 * q) = w; }
    }
}


constexpr int YQ_CMP = 256;
__device__ __forceinline__ void cmp_block(const Params& P, LAS char* lds, int b, int g, int qb) {
    using namespace fa;
    unsigned char* ws = P.ws;
    const bf16* QKV = (const bf16*)(ws + WS_QKV);
    const float* GATE = (const float*)(ws + WS_GATE);
    int tid_ = threadIdx.x; asm volatile("" : "+v"(tid_));
    const int tid = tid_, wid = __builtin_amdgcn_readfirstlane(tid >> 6), lane = tid & 63, r32 = lane & 31, hi = lane >> 5;
    const int tok = r32 >> 2, hh = r32 & 3, h = 4 * g + hh, bg = b * 2 + g;
    const int t = 64 * qb + 8 * wid + tok, row = b * SEQ + t;
    const bf16* qp = head_ptr(QKV, HB_QA + h, b) + (size_t)t * HD;
    bf16x8 qr[8];
#pragma unroll
    for (int d0 = 0; d0 < 8; ++d0) qr[d0] = *(const bf16x8*)(qp + d0 * 16 + hi * 8);
    Blk B{}; B.K = (const bf16*)(ws + WS_KC) + (size_t)bg * 256 * HD; B.V = (const bf16*)(ws + WS_VC) + (size_t)bg * 256 * HD; B.kvstride = HD;
    const int NT = (4 * qb + 66) >> 6;
    const int pos = (t >= 31 ? ((t - 15) >> 4) : 0) - 1, qm = pos - 4 * hi;
    const int tl = 64 * qb + 8 * wid + 7, posmax = (tl >= 31 ? ((tl - 15) >> 4) : 0) - 1;
    const int sr = tid >> 4, sc = (tid & 15) * 8, kws = FA_KSWZ(sr, sc * 2), vst0 = v_st(sr, sc), vst1 = v_st(32 + sr, sc);
    const int vb0 = (int)(unsigned)(size_t)(lds) + v_rd_base(lane);
    float m_reg = -1e30f, l_reg = 0.f, mn, alpha;
    Stage S; Extra X{};
    f32x16 p0, p1;
    stage_load<3>(S, B, X, 0, sr, sc, tid); asm volatile("s_waitcnt vmcnt(0)" ::: "memory"); stage_write<3>(S, lds, 0, kws, vst0, vst1, 0.f, tid); __syncthreads();
#define CMP_P1(T) if ((T) < NT) { \
        if ((T) + 1 < NT) stage_load<3>(S, B, X, (T) + 1, sr, sc, tid); \
        if (64 * (T) <= posmax) { FA_SBAR(); qkt<(T) & 1>(p0, p1, lds, r32, hi, qr); mask_tile(p0, p1, qm - 64 * (T), 1u << 30); partialSM(p0, p1, m_reg, mn, alpha); \
            float ps_ = 0.f; _Pragma("unroll") for (int r = 0; r < 16; ++r) ps_ += p0[r] + p1[r]; \
            { auto rr = __builtin_amdgcn_permlane32_swap(__float_as_uint(ps_), __float_as_uint(ps_), false, false); ps_ = __uint_as_float(rr[0]) + __uint_as_float(rr[1]); } \
            l_reg = l_reg * alpha + ps_; } \
        if ((T) + 1 < NT) { asm volatile("s_waitcnt vmcnt(0)" ::: "memory"); stage_write<3>(S, lds, ((T) & 1) ^ 1, kws, vst0, vst1, 0.f, tid); } \
        __syncthreads(); }
    CMP_P1(0) CMP_P1(1) CMP_P1(2) CMP_P1(3)
#undef CMP_P1
    const float inv_l = l_reg > 0.f ? 1.0f / l_reg : 0.f, mC = -m_reg * C2;
    f32x16 o[4];
#pragma unroll
    for (int d = 0; d < 4; ++d) o[d] = f32x16{};
    float IMP[4][8];
#pragma unroll
    for (int a = 0; a < 4; ++a)
#pragma unroll
        for (int k = 0; k < 8; ++k) IMP[a][k] = 0.f;
    bf16x8 pa0, pa1, pa2, pa3;
    stage_load<3>(S, B, X, 0, sr, sc, tid); asm volatile("s_waitcnt vmcnt(0)" ::: "memory"); stage_write<3>(S, lds, 0, kws, vst0, vst1, 0.f, tid); __syncthreads();
#define CMP_P2(T) if ((T) < NT) { \
        if ((T) + 1 < NT) stage_load<3>(S, B, X, (T) + 1, sr, sc, tid); \
        if (64 * (T) <= posmax) { FA_SBAR(); qkt<(T) & 1>(p0, p1, lds, r32, hi, qr); mask_tile(p0, p1, qm - 64 * (T), 1u << 30); \
            _Pragma("unroll") for (int r = 0; r < 16; ++r) { p0[r] = __builtin_amdgcn_exp2f(fmaf(p0[r], C2, mC)) * inv_l; p1[r] = __builtin_amdgcn_exp2f(fmaf(p1[r], C2, mC)) * inv_l; } \
            float A_[8], R_[8]; \
            _Pragma("unroll") for (int k = 0; k < 4; ++k) { A_[k] = p0[4 * k] + 2.f * (p0[4 * k + 1] + p0[4 * k + 2] + p0[4 * k + 3]); A_[4 + k] = p1[4 * k] + 2.f * (p1[4 * k + 1] + p1[4 * k + 2] + p1[4 * k + 3]); \
                R_[k] = swap32(p0[4 * k], hi); R_[4 + k] = swap32(p1[4 * k], hi); } \
            _Pragma("unroll") for (int k = 0; k < 8; ++k) IMP[T][k] += A_[k] + (hi ? (k < 7 ? R_[k < 7 ? k + 1 : 7] : 0.f) : R_[k]); \
            if ((T) > 0) IMP[(T) > 0 ? (T) - 1 : 0][7] += hi ? R_[0] : 0.f; \
            FA_PK4(p0, 0, pa0); FA_PK4(p0, 8, pa1); FA_PK4(p1, 0, pa2); FA_PK4(p1, 8, pa3); FA_SBAR(); \
            pv_tile<(T) & 1>(o, vb0, pa0, pa1, pa2, pa3); } \
        if ((T) + 1 < NT) { asm volatile("s_waitcnt vmcnt(0)" ::: "memory"); stage_write<3>(S, lds, ((T) & 1) ^ 1, kws, vst0, vst1, 0.f, tid); } \
        __syncthreads(); }
    CMP_P2(0) CMP_P2(1) CMP_P2(2) CMP_P2(3)
#undef CMP_P2
    { float scl[16]; const float g0 = sigmoidf_(GATE[(size_t)row * 32 + 3 * h]);
      row_scales(lds, wid, r32, hi, g0, scl);
      float* oc = (float*)(ws + WS_OCMP) + (size_t)(b * SEQ + 64 * qb + 8 * wid) * 1024 + 4 * g * 128;
#pragma unroll
      for (int r = 0; r < 16; ++r) { const int orow = crow(r, hi);
#pragma unroll
          for (int d0 = 0; d0 < 4; ++d0) oc[(size_t)(orow >> 2) * 1024 + (orow & 3) * 128 + d0 * 32 + r32] = o[d0][r] * scl[r]; } }
    unsigned long long* SELp = (unsigned long long*)(ws + WS_SEL) + (size_t)bg * SEQ + 64 * qb + 8 * wid;
    if (qb < 16) { if (lane < 8) SELp[lane] = 0xFFFFull; }
    else {
        LAS float* scs = (LAS float*)(lds + 73728) + wid * 512;
#pragma unroll
        for (int a = 0; a < 4; ++a)
#pragma unroll
            for (int k = 0; k < 8; ++k) { float v = IMP[a][k]; v += __shfl_xor(v, 1); v += __shfl_xor(v, 2); if (hh == 0) scs[tok * 64 + 16 * a + 2 * k + hi] = v; }
        asm volatile("s_waitcnt lgkmcnt(0)" ::: "memory");
        const int j = lane; const bool causal = j <= qb, forced = (j == 0) || (j == qb) || (j == qb - 1);
        for (int tk = 0; tk < 8; ++tk) {
            const float imp = scs[tk * 64 + lane];
            const float score = causal ? (forced ? 1e9f : imp) : -1.f;
            int rank = 0;
#pragma unroll 16
            for (int jj = 0; jj < 64; ++jj) { const float sj = __shfl(score, jj); rank += (sj > score || (sj == score && jj < j)) ? 1 : 0; }
            const unsigned long long mask = __ballot(rank < 16);
            if (lane == 0) SELp[tk] = mask;
        }
        asm volatile("s_waitcnt lgkmcnt(0)" ::: "memory");
    }
}
namespace pg8 {
struct CmpOrder {
    int c;
    __device__ __forceinline__ bool next(int i, Unit& u) const { if (i != 0 || c >= 8) return false; u.pm = c; u.pn = c >> 2; u.idx = 0; return true; }
    __device__ __forceinline__ void a_ready(const Unit&) const {}
    __device__ __forceinline__ void done(const Unit&) const {}
};
struct EpiCmp {
    static constexpr bool PERM = true, AFTER_DRAIN = true;
    bf16_t* hid; const bf16_t* w2t; const PG8_LAS float* bias; bf16_t* kcb; bf16_t* vcb;
    __device__ __forceinline__ void fused(f32x4 (&acc)[2][2][4][2], const Unit& u, int wr, int wc, int fr, int fq, PG8_LAS unsigned char* lds, int wid, int lane) const {
        const int kv = u.pn, row0 = u.pm * BM + wr * 64 + fr;
#pragma unroll
        for (int bj = 0; bj < 2; ++bj) { const int col = bj * HALF + wc * 32 + 8 * fq;
            const f32x4 b0 = *(const PG8_LAS f32x4*)(bias + col), b1 = *(const PG8_LAS f32x4*)(bias + col + 4);
#pragma unroll
            for (int ai = 0; ai < 2; ++ai)
#pragma unroll
                for (int m = 0; m < 4; ++m) { f32x4 v0 = acc[ai][bj][m][0] + b0, v1 = acc[ai][bj][m][1] + b1;
#pragma unroll
                    for (int i = 0; i < 4; ++i) { { const float x = v0[i], uu = 0.7978845608028654f * (x + 0.044715f * x * x * x), e = __expf(2.f * uu); v0[i] = 0.5f * x * (1.0f + (1.0f - 2.0f / (e + 1.0f))); }
                                                  { const float x = v1[i], uu = 0.7978845608028654f * (x + 0.044715f * x * x * x), e = __expf(2.f * uu); v1[i] = 0.5f * x * (1.0f + (1.0f - 2.0f / (e + 1.0f))); } }
                    u32x4 w; w.x = cvt_pk_bf16(v0[0], v0[1]); w.y = cvt_pk_bf16(v0[2], v0[3]); w.z = cvt_pk_bf16(v1[0], v1[1]); w.w = cvt_pk_bf16(v1[2], v1[3]);
                    *(u32x4*)(hid + (size_t)(row0 + ai * HALF + m * 16) * 256 + col) = w; } }
        asm volatile("s_waitcnt vmcnt(0)" ::: "memory"); __syncthreads();
        __builtin_amdgcn_fence(__ATOMIC_ACQUIRE, "agent"); asm volatile("s_waitcnt vmcnt(0)" ::: "memory");
        typedef float f32x16 __attribute__((ext_vector_type(16)));
        const int r32 = lane & 31, hi = lane >> 5;
        const bf16_t* hp = hid + (size_t)(u.pm * BM + wid * 32 + r32) * 256 + hi * 8;
        const bf16_t* wp = w2t + (size_t)kv * 128 * 256 + (size_t)r32 * 256 + hi * 8;
        f32x16 c2[4];
#pragma unroll
        for (int nt = 0; nt < 4; ++nt) c2[nt] = f32x16{};
#pragma unroll 4
        for (int ks = 0; ks < 16; ++ks) { const bf16x8 a = *(const bf16x8*)(hp + ks * 16);
#pragma unroll
            for (int nt = 0; nt < 4; ++nt) { const bf16x8 bb = *(const bf16x8*)(wp + (size_t)nt * 32 * 256 + ks * 16); c2[nt] = __builtin_amdgcn_mfma_f32_32x32x16_bf16(a, bb, c2[nt], 0, 0, 0); } }
        const int g = (u.pm >> 1) & 1, b = u.pm & 1, bgd = b * 2 + g;
        bf16_t* dst = (kv ? vcb : kcb) + (size_t)bgd * 256 * 128;
#pragma unroll
        for (int nt = 0; nt < 4; ++nt)
#pragma unroll
            for (int r = 0; r < 16; ++r) { const int crow_ = (r & 3) + 8 * (r >> 2) + 4 * hi; const float v = c2[nt][r];
                dst[(size_t)(wid * 32 + crow_) * 128 + nt * 32 + r32] = (bf16_t)((__builtin_bit_cast(unsigned, v) + 0x7fffu + ((__builtin_bit_cast(unsigned, v) >> 16) & 1u)) >> 16); }
    }
};
}


constexpr int XQ_SB = 256, XQ_TOTAL = XQ_SB + YQ_DIL, ZQ_TOTAL = 512;
__constant__ unsigned short ZTAB[ZQ_TOTAL] = {252, 253, 254, 255, 248, 249, 250, 251, 244, 245, 246, 247, 240, 241, 242, 243, 236, 237, 238, 239, 232, 233, 234, 235, 228, 229, 230, 231, 224, 225, 226, 227, 220, 221, 222, 223, 216, 217, 218, 219, 212, 213, 214, 215, 208, 209, 210, 211, 33008, 33009, 33010, 33011, 33012, 33013, 33014, 33015, 33016, 33017, 33018, 33019, 33020, 33021, 33022, 33023, 204, 205, 206, 207, 200, 201, 202, 203, 196, 197, 198, 199, 192, 193, 194, 195, 32992, 32993, 32994, 32995, 32996, 32997, 32998, 32999, 33000, 33001, 33002, 33003, 33004, 33005, 33006, 33007, 188, 189, 190, 191, 184, 185, 186, 187, 180, 181, 182, 183, 176, 177, 178, 179, 32976, 32977, 32978, 32979, 32980, 32981, 32982, 32983, 32984, 32985, 32986, 32987, 32988, 32989, 32990, 32991, 172, 173, 174, 175, 168, 169, 170, 171, 164, 165, 166, 167, 160, 161, 162, 163, 32960, 32961, 32962, 32963, 32964, 32965, 32966, 32967, 32968, 32969, 32970, 32971, 32972, 32973, 32974, 32975, 156, 157, 158, 159, 152, 153, 154, 155, 148, 149, 150, 151, 144, 145, 146, 147, 32944, 32945, 32946, 32947, 32948, 32949, 32950, 32951, 32952, 32953, 32954, 32955, 32956, 32957, 32958, 32959, 140, 141, 142, 143, 136, 137, 138, 139, 132, 133, 134, 135, 128, 129, 130, 131, 32928, 32929, 32930, 32931, 32932, 32933, 32934, 32935, 32936, 32937, 32938, 32939, 32940, 32941, 32942, 32943, 124, 125, 126, 127, 120, 121, 122, 123, 116, 117, 118, 119, 112, 113, 114, 115, 32912, 32913, 32914, 32915, 32916, 32917, 32918, 32919, 32920, 32921, 32922, 32923, 32924, 32925, 32926, 32927, 108, 109, 110, 111, 104, 105, 106, 107, 100, 101, 102, 103, 96, 97, 98, 99, 32896, 32897, 32898, 32899, 32900, 32901, 32902, 32903, 32904, 32905, 32906, 32907, 32908, 32909, 32910, 32911, 92, 93, 94, 95, 88, 89, 90, 91, 84, 85, 86, 87, 80, 81, 82, 83, 32880, 32881, 32882, 32883, 32884, 32885, 32886, 32887, 32888, 32889, 32890, 32891, 32892, 32893, 32894, 32895, 76, 77, 78, 79, 72, 73, 74, 75, 68, 69, 70, 71, 64, 65, 66, 67, 32864, 32865, 32866, 32867, 32868, 32869, 32870, 32871, 32872, 32873, 32874, 32875, 32876, 32877, 32878, 32879, 60, 61, 62, 63, 56, 57, 58, 59, 52, 53, 54, 55, 48, 49, 50, 51, 32848, 32849, 32850, 32851, 32852, 32853, 32854, 32855, 32856, 32857, 32858, 32859, 32860, 32861, 32862, 32863, 44, 45, 46, 47, 40, 41, 42, 43, 36, 37, 38, 39, 32, 33, 34, 35, 32832, 32833, 32834, 32835, 32836, 32837, 32838, 32839, 32840, 32841, 32842, 32843, 32844, 32845, 32846, 32847, 28, 29, 30, 31, 24, 25, 26, 27, 20, 21, 22, 23, 16, 17, 18, 19, 32816, 32817, 32818, 32819, 32820, 32821, 32822, 32823, 32824, 32825, 32826, 32827, 32828, 32829, 32830, 32831, 12, 13, 14, 15, 8, 9, 10, 11, 4, 5, 6, 7, 0, 1, 2, 3, 32800, 32801, 32802, 32803, 32804, 32805, 32806, 32807, 32808, 32809, 32810, 32811, 32812, 32813, 32814, 32815, 32784, 32785, 32786, 32787, 32788, 32789, 32790, 32791, 32792, 32793, 32794, 32795, 32796, 32797, 32798, 32799, 32768, 32769, 32770, 32771, 32772, 32773, 32774, 32775, 32776, 32777, 32778, 32779, 32780, 32781, 32782, 32783};
__device__ __forceinline__ int queue_pop(LAS char* lds, unsigned* qctr) {
    volatile LAS int* qslot = (volatile LAS int*)(lds + fa::L_MISC);
    if (threadIdx.x == 0) qslot[0] = (int)__hip_atomic_fetch_add(qctr, 1u, __ATOMIC_RELAXED, __HIP_MEMORY_SCOPE_AGENT);
    __syncthreads();
    const int item = __builtin_amdgcn_readfirstlane(qslot[0]);
    __syncthreads();
    return item;
}
__device__ __forceinline__ void phaseX_queue(const Params& P, LAS unsigned char* lds_, unsigned* qctr) {
    LAS char* lds = (LAS char*)lds_;
    for (;;) {
        const int item = queue_pop(lds, qctr);
        if (item >= XQ_TOTAL) break;
        if (item < XQ_SB) { const int bh = item & 15, x = 15 - (item >> 4); sbk_block(P, lds, bh >> 3, bh & 7, x); }
        else { const int it = item - XQ_SB, cfg = it / 256, r = it % 256, bh = r & 15, blk = r >> 4; dil_block(P, lds, cfg, bh >> 3, bh & 7, blk); }
    }
}
__device__ __forceinline__ void phaseZ_queue(const Params& P, LAS unsigned char* lds_, unsigned* qctr) {
    LAS char* lds = (LAS char*)lds_;
    for (;;) {
        const int item = queue_pop(lds, qctr);
        if (item >= ZQ_TOTAL) break;
        const unsigned code = ZTAB[item];
        if ((code >> 15) == 0u) { const int bg = code & 3, qb = (code >> 2) & 63;
            cmp_block(P, lds, bg >> 1, bg & 1, qb);
            asm volatile("s_waitcnt vmcnt(0)" ::: "memory"); __syncthreads(); __builtin_amdgcn_fence(__ATOMIC_ACQUIRE, "agent"); asm volatile("s_waitcnt vmcnt(0)" ::: "memory");
            nsa_block(P, lds, bg >> 1, bg & 1, qb); }
        else { const int bh = code & 15, x = (code >> 4) & 15; fox_block(P, lds, bh >> 3, bh & 7, x); }
    }
}

__device__ __forceinline__ void cumsum_wave(const Params& P, int l, int idx, int lane) {
    unsigned char* ws = P.ws; const float* GATE = (const float*)(ws + WS_GATE);
    const int b = idx >> 3, h = idx & 7; const float fb = ((const float*)P.in[I_FOXB])[l * 8 + h];
    float* cum = (float*)(ws + WS_CUM) + (size_t)idx * SEQ;
    double s = 0.0;
    for (int i = 0; i < 64; ++i) { const int t = lane * 64 + i; s += (double)log_sigmoid_f(GATE[(size_t)(b * SEQ + t) * 32 + 24 + h] + fb); }
    double incl = s;
#pragma unroll
    for (int o = 1; o < 64; o <<= 1) { const double y = __shfl_up(incl, o); if (lane >= o) incl += y; }
    double run = incl - s;
    for (int i = 0; i < 64; ++i) { const int t = lane * 64 + i; run += (double)log_sigmoid_f(GATE[(size_t)(b * SEQ + t) * 32 + 24 + h] + fb); cum[t] = (float)run; }
}

#ifndef REP_PHASE
#define REP_PHASE (-1)
#endif
#define NREP(k) (((k) == REP_PHASE) ? 2 : 1)
template <int l>
__device__ __forceinline__ void layer_phases(const Params& P, LAS unsigned char* lds, const XcdBarrier& bar, const int lo, const int hi) {
    int tid_ = threadIdx.x; asm volatile("" : "+v"(tid_));
    const int tid = tid_, lane = tid & 63, wave = __builtin_amdgcn_readfirstlane(tid >> 6);
    const int G = gridDim.x, blk = blockIdx.x;
    const int gw = blk * NWAVES + wave, NGW = G * NWAVES;
    unsigned char* ws = P.ws;
#define IN(k) (lo <= (k) && (k) < hi)
#define SEAM(k) do { if ((k) + 1 < hi) xcd_barrier(bar); } while (0)
#define PHASE(k) if (IN(k)) for (int rep = 0; rep < NREP(k); ++rep)
#define REPBAR() do { if (rep) xcd_barrier(bar); } while (0)
    const int pb = 1 + PH_PER_LAYER * l;
    unsigned char* wl = ws + WS_W + (size_t)l * LAYER_W;
    bf16* H = (bf16*)(ws + WS_H);
    const void* hin = l == 0 ? (const void*)P.in[I_X] : (const void*)H;
    bf16* XN = (bf16*)(ws + WS_XN);
    float* SSA = (float*)(ws + WS_SSA); float* SSB = (float*)(ws + WS_SSB);
    unsigned* qc = (unsigned*)(ws + WS_CTL) + 64 * (8 + 8 * l);
    PHASE(pb + 0) { REPBAR();
        { pg8::Gemm g{(const bf16*)(ws + WS_XN8), (const bf16*)(wl + W_IN + W_IN8), MROWS, N8P * 256, DM}; pg8::StaticOrder S; S.init(MROWS, N8P * 256, G, blk);
          if (l > 0) rstd_prepass(lds, S, SSA);
          pg8::EpiProj<(l > 0), true> E{(bf16*)(ws + WS_QKV), (float*)(ws + WS_GATE), (const float*)(ws + WS_ROPE), (const LAS float*)(lds + LRSTD_OFF)};
          pg8::gemm_phase<pg8::EpiProj<(l > 0), true>, pg8::StaticOrder, true, true, true, 0x79797979>(lds + RING_OFF, g, S, E); }
        { pg8::Gemm g{l == 0 ? XN : (const bf16*)H, (const bf16*)(wl + W_IN), MROWS, N16P * 256, DM}; pg8::StaticOrder S; S.init(MROWS, N16P * 256, G, blk);
          if (l > 0) rstd_prepass(lds, S, SSA);
          pg8::EpiProj<(l > 0), false> E{(bf16*)(ws + WS_QKV), (float*)(ws + WS_GATE), (const float*)(ws + WS_ROPE), (const LAS float*)(lds + LRSTD_OFF)};
          pg8::gemm_phase<pg8::EpiProj<(l > 0), false>, pg8::StaticOrder, true, true>(lds + RING_OFF, g, S, E); } }
    if (IN(pb + 0)) SEAM(pb + 0);
    PHASE(pb + 1) { REPBAR();
        if (blk < 8) { LAS float* lbias = (LAS float*)(lds + LDSCTL_OFF + 1024); const int kv = blk >> 2;
            if (tid < 256) { const float* p = (const float*)(ws + WS_CBP) + (size_t)((l * 2 + kv) * 64) * 256 + tid; float s = 0.f;
#pragma unroll 16
                for (int kc = 0; kc < 64; ++kc) s += p[(size_t)kc * 256];
                lbias[tid] = s; }
            __syncthreads();
            pg8::Gemm g{(const bf16*)(ws + WS_QKV) + (size_t)16 * SEQ * HD, (const bf16*)(wl + W_C1K), 2048, 512, 4096, 2048, 4096}; pg8::CmpOrder S{blk};
            pg8::EpiCmp E{(bf16*)(ws + WS_HID), (const bf16*)(wl + W_C2K), (const LAS float*)lbias, (bf16*)(ws + WS_KC), (bf16*)(ws + WS_VC)};
            pg8::gemm_phase<pg8::EpiCmp, pg8::CmpOrder, false, true>(lds + RING_OFF, g, S, E);
            }
        if (gw >= 64 && gw < 80) cumsum_wave(P, l, gw - 64, lane);
        __syncthreads();
        phaseX_queue(P, lds, qc + 64 * rep); }
    if (IN(pb + 1)) SEAM(pb + 1);
    PHASE(pb + 2) { REPBAR(); phaseZ_dil_combine(P, gw, NGW, lane); phaseZ_queue(P, lds, qc + 128 + 64 * rep); }
    if (IN(pb + 2)) SEAM(pb + 2);
    PHASE(pb + 3) { REPBAR();
        pg8::Gemm g{(const bf16*)(ws + WS_MIX), (const bf16*)(wl + W_O), MROWS, DM, DM}; pg8::StaticOrder S; S.init(MROWS, DM, G, blk);
        pg8::EpiResid<(l == 0), false> E{hin, H, DM, nullptr, SSA};
        pg8::gemm_phase<pg8::EpiResid<(l == 0), false>, pg8::StaticOrder, true, true>(lds + RING_OFF, g, S, E); }
    if (IN(pb + 3)) SEAM(pb + 3);
    PHASE(pb + 4) { REPBAR();
        pg8::Gemm g{H, (const bf16*)(wl + W_UP), MROWS, DFF, DM}; pg8::StaticOrder S; S.init(MROWS, DFF, G, blk);
        rstd_prepass(lds, S, SSA);
        pg8::EpiAct<2> E{(bf16*)(ws + WS_FF), DFF, (const LAS float*)(lds + LRSTD_OFF)};
        pg8::gemm_phase<pg8::EpiAct<2>, pg8::StaticOrder, true, true>(lds + RING_OFF, g, S, E); }
    if (IN(pb + 4)) SEAM(pb + 4);
    PHASE(pb + 5) { REPBAR();
        pg8::Gemm g{(const bf16*)(ws + WS_FF), (const bf16*)(wl + W_DN), MROWS, DM, DFF}; pg8::StaticOrder S; S.init(MROWS, DM, G, blk);
        pg8::EpiResid<false, true> E{H, H, DM, (unsigned char*)XN, SSB};
        pg8::gemm_phase<pg8::EpiResid<false, true>, pg8::StaticOrder, true, true>(lds + RING_OFF, g, S, E); }
    if (IN(pb + 5)) SEAM(pb + 5);
    PHASE(pb + 6) { REPBAR();
        { pg8::Gemm g{(const bf16*)(ws + WS_PB) + (size_t)l * MROWS * PLE, (const bf16*)(wl + W_PP), MROWS, DM, PLE}; pg8::StaticOrder S; S.init(MROWS, DM, G, blk);
          pg8::EpiAct<0> E{(bf16*)(ws + WS_PP), DM, nullptr};
          pg8::gemm_phase<pg8::EpiAct<0>, pg8::StaticOrder, true, true>(lds + RING_OFF, g, S, E); }
        VM_WAIT(); __builtin_amdgcn_fence(__ATOMIC_ACQUIRE, "agent"); VM_WAIT(); __syncthreads();
        { pg8::Gemm g{XN, (const bf16*)(wl + W_G), MROWS, DM, DM}; pg8::StaticOrder S; S.init(MROWS, DM, G, blk);
          rstd_prepass(lds, S, SSB);
          pg8::EpiPle<(l + 1 < DEPTH)> E{H, (const bf16*)(ws + WS_PP), DM, (const LAS float*)(lds + LRSTD_OFF), SSA, ws + WS_XN8};
          pg8::gemm_phase<pg8::EpiPle<(l + 1 < DEPTH)>, pg8::StaticOrder, true, true, true, 0x79797979>(lds + RING_OFF, g, S, E); } }
    if (IN(pb + 6)) SEAM(pb + 6);
#undef IN
#undef SEAM
#undef PHASE
#undef REPBAR
}


__global__ void __launch_bounds__(NTHREADS, 2) hybrid_fwd(Params P) {
    extern __shared__ __attribute__((aligned(16))) unsigned char lds_raw[];
    LAS unsigned char* lds = (LAS unsigned char*)lds_raw;
    volatile LAS unsigned* MISC = (volatile LAS unsigned*)(lds + MISC_OFF);
    const int tid = threadIdx.x, lane = tid & 63, wave = __builtin_amdgcn_readfirstlane(tid >> 6);
    const int G = gridDim.x, blk = blockIdx.x;
    const int gw = blk * NWAVES + wave, NGW = G * NWAVES;
    unsigned char* ws = P.ws;
    for (int u = tid; u < (LDS_BYTES - LDSCTL_OFF) / 4; u += NTHREADS) ((LAS unsigned*)(lds + LDSCTL_OFF))[u] = 0u;
    __syncthreads();
    XcdBarrier bar = xcd_barrier_post((unsigned*)(ws + WS_CTL) + CW_BAR, MISC + 8);
    const int lo = P.ph_lo, hi = P.ph_hi;
#define IN(k) (lo <= (k) && (k) < hi)
#define SEAM(k) do { if ((k) + 1 < hi) xcd_barrier(bar); } while (0)

    #ifndef NO_P0
    if (IN(0)) { for (int rep = 0; rep < NREP(0); ++rep) { if (rep) xcd_barrier(bar); prologue_phase(P, lds, gw, NGW, wave, lane, rep); } SEAM(0); }
#endif

    layer_phases<0>(P, lds, bar, lo, hi);
    layer_phases<1>(P, lds, bar, lo, hi);
    if (IN(NPH - 1)) {
        norm_phase<true, true>((const float*)(ws + WS_H), (const float*)P.in[I_NFIN], P.out, gw, NGW, lane);
    }
#undef IN
#undef SEAM
}

#ifndef N_LAUNCH_MODE
#define N_LAUNCH_MODE 1
#endif
extern "C" void kernel_launch(void* const* d_in, const int* in_sizes, int n_in, void* d_out, int out_size, void* d_ws, size_t ws_size, hipStream_t stream) {
    static int grid = 0;
    if (grid == 0) {
        if (n_in != 20 || in_sizes[0] != MROWS * DM || out_size != MROWS * DM || ws_size < WS_END) { fprintf(stderr, "kernel_launch: unexpected shapes (n_in %d, in0 %d, out %d, ws %zu)\n", n_in, n_in > 0 ? in_sizes[0] : -1, out_size, ws_size); grid = -1; return; }
        int dev = 0, cus = 0, per_cu = 0;
        if (hipGetDevice(&dev) != hipSuccess || hipDeviceGetAttribute(&cus, hipDeviceAttributeMultiprocessorCount, dev) != hipSuccess) { grid = -1; return; }
        if (hipFuncSetAttribute((const void*)hybrid_fwd, hipFuncAttributeMaxDynamicSharedMemorySize, LDS_BYTES) != hipSuccess) { fprintf(stderr, "kernel_launch: hipFuncSetAttribute failed\n"); grid = -1; return; }
        if (hipOccupancyMaxActiveBlocksPerMultiprocessor(&per_cu, (const void*)hybrid_fwd, NTHREADS, LDS_BYTES) != hipSuccess || per_cu < 1) fprintf(stderr, "kernel_launch: occupancy query reports %d\n", per_cu);
        (void)hipGetLastError();
        grid = cus;
    }
    if (grid < 0) return;
    if (hipMemsetAsync((char*)d_ws + WS_CTL, 0, CTL_ZERO_BYTES, stream) != hipSuccess) return;
    Params p{};
    for (int i = 0; i < 20; ++i) p.in[i] = d_in[i];
    p.out = (float*)d_out; p.ws = (unsigned char*)d_ws;
#if N_LAUNCH_MODE == 1
    p.ph_lo = 0; p.ph_hi = NPH;
    hipLaunchKernelGGL(hybrid_fwd, dim3(grid), dim3(NTHREADS), LDS_BYTES, stream, p);
#else
    for (int k = 0; k < NPH; ++k) { p.ph_lo = k; p.ph_hi = k + 1; hipLaunchKernelGGL(hybrid_fwd, dim3(grid), dim3(NTHREADS), LDS_BYTES, stream, p); }
#endif
}
```

```cpp
#include <hip/hip_runtime.h>
#include <cstdio>
#include <cstdint>
#include <cmath>
namespace pg8 {
#define PG8_LAS __attribute__((address_space(3)))
typedef unsigned short bf16_t;
typedef short bf16x8 __attribute__((ext_vector_type(8)));
typedef float f32x4 __attribute__((ext_vector_type(4)));
typedef unsigned u32x4 __attribute__((ext_vector_type(4)));
typedef int i32x4_t __attribute__((ext_vector_type(4)));
typedef int i32x8_t __attribute__((ext_vector_type(8)));
constexpr int BM = 256, BK = 64, HALF = 128, HTB = HALF * BK * 2  , STAGE_BYTES = 8 * HTB, NXCD = 8, WGM = 8;

__host__ __device__ __forceinline__ int lds_byte(int r, int c) { const int st = (r >> 4) * 2 + (c >> 5), rr = r & 15, cc = c & 31, ob = rr * 64 + cc * 2; return st * 1024 + (ob ^ (((ob >> 9) & 1) << 5)); }
__host__ __device__ __forceinline__ void stage_rc(int b, int& R, int& C) { const int st = b / 1024, sb = b % 1024, swz = sb ^ (((sb >> 9) & 1) << 5); R = (st >> 1) * 16 + swz / 64; C = (st & 1) * 32 + (swz % 64) / 2; }
__host__ __device__ __forceinline__ int perm32(int rho) { const int n = rho >> 4, i = rho & 15; return 8 * (i >> 2) + 4 * n + (i & 3); }

struct Unit { int pm, pn, idx; };
struct Gemm { const bf16_t* A; const bf16_t* Bt; int M, N, K; int lda = 0, ldb = 0; };

struct StaticOrder {
    int nM, nN, nwg, G, c;
    __host__ __device__ void init(int M, int N, int G_, int c_) { nM = M / BM; nN = N / BM; nwg = nM * nN; G = G_; c = c_; }
    __host__ __device__ bool next(int i, Unit& u) const {
        const long L = (long)i * G + c; if (L >= nwg) return false;
        int wgid = (int)L; { const int q = nwg / NXCD, r = nwg % NXCD, xcd = wgid % NXCD, off = wgid / NXCD; wgid = (xcd < r ? xcd * (q + 1) : r * (q + 1) + (xcd - r) * q) + off; }
        const int nig = WGM * nN, gid = wgid / nig, fm = gid * WGM, gsz = (nM - fm) < WGM ? (nM - fm) : WGM;
        u.pm = fm + ((wgid % nig) % gsz); u.pn = (wgid % nig) / gsz; u.idx = i; return true;
    }
    __device__ __forceinline__ void a_ready(const Unit&) const {}
    __device__ __forceinline__ void done(const Unit&) const {}
};

__device__ __forceinline__ unsigned cvt_pk_bf16(float lo, float hi) { unsigned r; asm volatile("v_cvt_pk_bf16_f32 %0, %1, %2" : "=v"(r) : "v"(lo), "v"(hi)); return r; }
typedef float f32x2 __attribute__((ext_vector_type(2)));
__device__ __forceinline__ f32x2 gelu_pk(f32x2 v) {
    const f32x2 av = __builtin_elementwise_abs(v), d = av * 0.2316418882f + 1.0f;
    f32x2 t; t.x = __builtin_amdgcn_rcpf(d.x); t.y = __builtin_amdgcn_rcpf(d.y);
    f32x2 q = t * 0.5307027145f + (-0.7265760135f); q = q * t + 0.7107068705f; q = q * t + (-0.142248368f); q = q * t + 0.127414796f; q = q * t;
    const f32x2 s = (v * v) * (-0.72134752044f);
    f32x2 e; e.x = __builtin_amdgcn_exp2f(s.x); e.y = __builtin_amdgcn_exp2f(s.y);
    const f32x2 m = v * (q * e), r = v - m;
    f32x2 o; o.x = v.x < 0.f ? m.x : r.x; o.y = v.y < 0.f ? m.y : r.y; return o;
}

template <class Epi, class Sched, bool ALIGN_EPI = false, bool SP2 = false, bool F8 = false, int SCALE_B = 0x7F7F7F7F>
__device__ __forceinline__ void gemm_phase(PG8_LAS unsigned char* lds, const Gemm g, const Sched& S, const Epi& E) {
    int tid_ = threadIdx.x; asm volatile("" : "+v"(tid_));
    const int tid = tid_, wid = __builtin_amdgcn_readfirstlane(tid >> 6), lane = tid & 63, wr = wid >> 2, wc = wid & 3, fr = lane & 15, fq = lane >> 4;
    int K_ = g.K; asm volatile("" : "+s"(K_)); const int K = K_, nt = K / (F8 ? 2 * BK : BK); constexpr int ESZ = F8 ? 1 : 2;
    const int lda = g.lda ? g.lda : K, ldb = g.ldb ? g.ldb : K;
    unsigned voffA[2], voffB[2];
#pragma unroll
    for (int i = 0; i < 2; ++i) { int R, C; stage_rc(tid * 16 + i * 8192, R, C); const int Rb = Epi::PERM ? ((R & ~31) + perm32(R & 31)) : R;
        voffA[i] = F8 ? (unsigned)(R * lda + 2 * C) : (unsigned)(R * lda + C) * 2u; voffB[i] = F8 ? (unsigned)(Rb * ldb + 2 * C) : (unsigned)(Rb * ldb + C) * 2u; }
    const size_t kstep = (size_t)(BK * 2);
    const size_t hstepA = (size_t)HALF * lda * ESZ, hstepB = (size_t)HALF * ldb * ESZ;
    const size_t tstepA = 2 * hstepA, tstepB = 2 * hstepB;
    const unsigned ldsw = (unsigned)wid * 1024u;
    const int aoff = lds_byte(wr * 64 + fr, fq * 8), boff = lds_byte(wc * 32 + fr, fq * 8);
#define PG8_SA(b, h) (((b) * 2 + (h)) * HTB)
#define PG8_SB(b, h) ((4 + (b) * 2 + (h)) * HTB)
#define PG8_STAGE(bufoff, gbase, voff) do { _Pragma("unroll") for (int _i = 0; _i < 2; ++_i) \
        __builtin_amdgcn_global_load_lds((const unsigned*)((const char*)(gbase) + (voff)[_i]), (PG8_LAS unsigned*)(lds + (bufoff) + ldsw + _i * 8192), 16, 0, 0); } while (0)
#define PG8_LDA(dst, b, h) do { _Pragma("unroll") for (int m = 0; m < 4; ++m) _Pragma("unroll") for (int k = 0; k < 2; ++k) dst[m][k] = *(const PG8_LAS bf16x8*)(lds + PG8_SA(b, h) + aoff + m * 2048 + k * 1024); } while (0)
#define PG8_LDB(dst, b, h) do { _Pragma("unroll") for (int n = 0; n < 2; ++n) _Pragma("unroll") for (int k = 0; k < 2; ++k) dst[n][k] = *(const PG8_LAS bf16x8*)(lds + PG8_SB(b, h) + boff + n * 2048 + k * 1024); } while (0)
#define PG8_CAT8(x, y) __builtin_shufflevector(__builtin_bit_cast(i32x4_t, x), __builtin_bit_cast(i32x4_t, y), 0, 1, 2, 3, 4, 5, 6, 7)
#define PG8_MMA(ai, bj, At, Bt) do { __builtin_amdgcn_s_setprio(1); if constexpr (F8) { i32x8_t a8_[4], b8_[2]; _Pragma("unroll") for (int m = 0; m < 4; ++m) a8_[m] = PG8_CAT8(At[m][0], At[m][1]); _Pragma("unroll") for (int n = 0; n < 2; ++n) b8_[n] = PG8_CAT8(Bt[n][0], Bt[n][1]); \
        _Pragma("unroll") for (int m = 0; m < 4; ++m) _Pragma("unroll") for (int n = 0; n < 2; ++n) \
        asm volatile("v_mfma_scale_f32_16x16x128_f8f6f4 %0, %1, %2, %0, %3, %4 op_sel_hi:[0,0,0]" : "+v"(acc[ai][bj][m][n]) : "v"(b8_[n]), "v"(a8_[m]), "v"(sclB_), "v"(sclA_)); } \
    else { _Pragma("unroll") for (int m = 0; m < 4; ++m) _Pragma("unroll") for (int n = 0; n < 2; ++n) _Pragma("unroll") for (int k = 0; k < 2; ++k) \
        acc[ai][bj][m][n] = __builtin_amdgcn_mfma_f32_16x16x32_bf16(Bt[n][k], At[m][k], acc[ai][bj][m][n], 0, 0, 0); } __builtin_amdgcn_s_setprio(0); } while (0)
#define PG8_WAIT_V(n) asm volatile("s_waitcnt vmcnt(" #n ")" ::: "memory")
#define PG8_WAIT_L(n) asm volatile("s_waitcnt lgkmcnt(" #n ")" ::: "memory")
#define PG8_BAR __builtin_amdgcn_s_barrier()
#define PG8_SCHED __builtin_amdgcn_sched_barrier(0)
    int sclA_ = 0x7F7F7F7F, sclB_ = SCALE_B; if constexpr (F8) { asm volatile("" : "+v"(sclA_), "+v"(sclB_)); }
    Unit cur, nxt; int ui = 0;
    if (!S.next(0, cur)) return;
    f32x4 acc[2][2][4][2];
#pragma unroll
    for (int a = 0; a < 2; ++a)
#pragma unroll
        for (int b = 0; b < 2; ++b)
#pragma unroll
            for (int m = 0; m < 4; ++m)
#pragma unroll
                for (int n = 0; n < 2; ++n) acc[a][b][m][n] = (f32x4){0.f, 0.f, 0.f, 0.f};
    bf16x8 At[4][2], B0[2][2], B1[2][2];
    const char* cA = (const char*)g.A + (size_t)cur.pm * tstepA; const char* cB = (const char*)g.Bt + (size_t)cur.pn * tstepB;
    S.a_ready(cur);
    if constexpr (SP2) {
        PG8_STAGE(PG8_SB(0, 0), cB, voffB); PG8_STAGE(PG8_SB(0, 1), cB + hstepB, voffB); PG8_STAGE(PG8_SA(0, 0), cA, voffA); PG8_STAGE(PG8_SA(0, 1), cA + hstepA, voffA);
        if (wr == 1) PG8_BAR;
        PG8_WAIT_V(2); PG8_BAR;
        PG8_STAGE(PG8_SB(1, 0), cB + kstep, voffB); PG8_STAGE(PG8_SA(1, 0), cA + kstep, voffA); PG8_STAGE(PG8_SB(1, 1), cB + hstepB + kstep, voffB);
        PG8_WAIT_V(6); PG8_BAR;
    } else {
        PG8_STAGE(PG8_SB(0, 0), cB, voffB); PG8_STAGE(PG8_SA(0, 0), cA, voffA); PG8_STAGE(PG8_SB(0, 1), cB + hstepB, voffB); PG8_STAGE(PG8_SA(0, 1), cA + hstepA, voffA);
        if (wr == 1) PG8_BAR;
        PG8_WAIT_V(4); PG8_BAR;
        PG8_STAGE(PG8_SB(1, 0), cB + kstep, voffB); PG8_STAGE(PG8_SA(1, 0), cA + kstep, voffA); PG8_STAGE(PG8_SB(1, 1), cB + hstepB + kstep, voffB);
        PG8_WAIT_V(6); PG8_BAR;
    }
    for (;;) {
        const bool has_next = S.next(ui + 1, nxt);
        const char* nA = has_next ? (const char*)g.A + (size_t)nxt.pm * tstepA : cA; const char* nB = has_next ? (const char*)g.Bt + (size_t)nxt.pn * tstepB : cB;
        for (int t = 0; t < nt; t += 2) {
            const bool last = (t == nt - 2);
            const char* a1 = cA + (size_t)(t + 1) * kstep;
            const char* a2 = last ? nA : cA + (size_t)(t + 2) * kstep; const char* b2 = last ? nB : cB + (size_t)(t + 2) * kstep;
            const char* a3 = a2 + kstep; const char* b3 = b2 + kstep;
            if (last && has_next) S.a_ready(nxt);
            if constexpr (SP2) {
            PG8_LDB(B0, 0, 0); PG8_LDB(B1, 0, 1); PG8_SCHED; PG8_LDA(At, 0, 0); PG8_STAGE(PG8_SA(1, 1), a1 + hstepA, voffA);
            PG8_WAIT_V(8); PG8_WAIT_L(0); PG8_BAR; PG8_MMA(0, 0, At, B0); PG8_MMA(0, 1, At, B1); PG8_BAR; PG8_SCHED;
            PG8_LDA(At, 0, 1); PG8_STAGE(PG8_SB(0, 0), b2, voffB); PG8_STAGE(PG8_SB(0, 1), b2 + hstepB, voffB); PG8_STAGE(PG8_SA(0, 0), a2, voffA);
            PG8_WAIT_V(8); PG8_WAIT_L(0); PG8_BAR; PG8_MMA(1, 0, At, B0); PG8_MMA(1, 1, At, B1); PG8_BAR; PG8_SCHED;
            PG8_LDB(B0, 1, 0); PG8_LDB(B1, 1, 1); PG8_SCHED; PG8_LDA(At, 1, 0); PG8_STAGE(PG8_SA(0, 1), a2 + hstepA, voffA);
            PG8_WAIT_V(8); PG8_WAIT_L(0); PG8_BAR; PG8_MMA(0, 0, At, B0); PG8_MMA(0, 1, At, B1); PG8_BAR; PG8_SCHED;
            PG8_LDA(At, 1, 1); PG8_STAGE(PG8_SB(1, 0), b3, voffB); PG8_STAGE(PG8_SB(1, 1), b3 + hstepB, voffB); PG8_STAGE(PG8_SA(1, 0), a3, voffA);
            PG8_WAIT_V(8); PG8_WAIT_L(0); PG8_BAR; PG8_MMA(1, 0, At, B0); PG8_MMA(1, 1, At, B1); PG8_BAR; PG8_SCHED;
            } else {
            PG8_LDB(B0, 0, 0); PG8_SCHED; PG8_LDA(At, 0, 0); PG8_STAGE(PG8_SA(1, 1), a1 + hstepA, voffA);
            PG8_WAIT_L(8); PG8_BAR; PG8_WAIT_L(0); PG8_MMA(0, 0, At, B0); PG8_BAR; PG8_SCHED;
            PG8_LDB(B1, 0, 1); PG8_STAGE(PG8_SB(0, 0), b2, voffB);
            PG8_BAR; PG8_WAIT_L(0); PG8_MMA(0, 1, At, B1); PG8_BAR;
            PG8_LDA(At, 0, 1); PG8_STAGE(PG8_SA(0, 0), a2, voffA);
            PG8_BAR; PG8_WAIT_L(0); PG8_MMA(1, 0, At, B0); PG8_BAR; PG8_SCHED;
            PG8_STAGE(PG8_SB(0, 1), b2 + hstepB, voffB);
            PG8_WAIT_V(6); PG8_BAR; PG8_MMA(1, 1, At, B1); PG8_BAR;
            PG8_LDB(B0, 1, 0); PG8_SCHED; PG8_LDA(At, 1, 0); PG8_STAGE(PG8_SA(0, 1), a2 + hstepA, voffA);
            PG8_WAIT_L(8); PG8_BAR; PG8_WAIT_L(0); PG8_MMA(0, 0, At, B0); PG8_BAR; PG8_SCHED;
            PG8_LDB(B1, 1, 1); PG8_STAGE(PG8_SB(1, 0), b3, voffB);
            PG8_BAR; PG8_WAIT_L(0); PG8_MMA(0, 1, At, B1); PG8_BAR;
            PG8_LDA(At, 1, 1); PG8_STAGE(PG8_SA(1, 0), a3, voffA);
            PG8_BAR; PG8_WAIT_L(0); PG8_MMA(1, 0, At, B0); PG8_BAR; PG8_SCHED;
            PG8_STAGE(PG8_SB(1, 1), b3 + hstepB, voffB);
            PG8_WAIT_V(6); PG8_BAR; PG8_MMA(1, 1, At, B1); PG8_BAR;
            }
        }
        if constexpr (F8) asm volatile("s_nop 15\n\ts_nop 15" ::: "memory");
        if constexpr (ALIGN_EPI) { if (wr == 0) PG8_BAR; }
        if constexpr (!Epi::AFTER_DRAIN) { E(acc, cur, wr, wc, fr, fq);
#ifdef DOUBLE_EPI
            if constexpr (Epi::IDEMPOTENT) { asm volatile("" ::: "memory"); E(acc, cur, wr, wc, fr, fq); }
#endif
            S.done(cur); }
        if (!has_next) break;
#pragma unroll
        for (int a = 0; a < 2; ++a)
#pragma unroll
            for (int b = 0; b < 2; ++b)
#pragma unroll
                for (int m = 0; m < 4; ++m)
#pragma unroll
                    for (int n = 0; n < 2; ++n) acc[a][b][m][n] = (f32x4){0.f, 0.f, 0.f, 0.f};
        cur = nxt; cA = nA; cB = nB; ++ui;
        if constexpr (ALIGN_EPI) { if (wr == 1) PG8_BAR; }
    }
    PG8_WAIT_V(0);
    if constexpr (!ALIGN_EPI) { if (wr == 0) PG8_BAR; }
    PG8_BAR;
    if constexpr (Epi::AFTER_DRAIN) { E.fused(acc, cur, wr, wc, fr, fq, lds, wid, lane); S.done(cur); }
#undef PG8_SA
#undef PG8_SB
#undef PG8_STAGE
#undef PG8_LDA
#undef PG8_LDB
#undef PG8_MMA
#undef PG8_CAT8
#undef PG8_WAIT_V
#undef PG8_WAIT_L
#undef PG8_BAR
#undef PG8_SCHED
}
}
namespace pg8 {
struct Gemm2 { const unsigned char* A; const unsigned char* B; int LD, OFF8, K8, K16; };
template <class Epi, class Sched, int SCALE_B>
__device__ __forceinline__ void gemm_phase_mixed(PG8_LAS unsigned char* lds, const Gemm2 g, const Sched& S, const Epi& E) {
    int tid_ = threadIdx.x; asm volatile("" : "+v"(tid_));
    const int tid = tid_, wid = __builtin_amdgcn_readfirstlane(tid >> 6), lane = tid & 63, wr = wid >> 2, wc = wid & 3, fr = lane & 15, fq = lane >> 4;
    int K8_ = g.K8, K16_ = g.K16; asm volatile("" : "+s"(K8_), "+s"(K16_)); const int n8 = K8_ / 128, n16 = K16_ / 64, NT = n8 + n16, LD = g.LD, O8 = g.OFF8;
    unsigned voffA[2], voffB[2];
#pragma unroll
    for (int i = 0; i < 2; ++i) { int R, C; stage_rc(tid * 16 + i * 8192, R, C); const int Rb = Epi::PERM ? ((R & ~31) + perm32(R & 31)) : R;
        voffA[i] = (unsigned)(R * LD + 2 * C); voffB[i] = (unsigned)(Rb * LD + 2 * C); }
    const size_t hstep = (size_t)HALF * LD, tstep = 2 * hstep;
    const unsigned ldsw = (unsigned)wid * 1024u;
    const int aoff = lds_byte(wr * 64 + fr, fq * 8), boff = lds_byte(wc * 32 + fr, fq * 8);
#define PG8_SA(b, h) (((b) * 2 + (h)) * HTB)
#define PG8_SB(b, h) ((4 + (b) * 2 + (h)) * HTB)
#define PG8_STAGE(bufoff, gbase, voff) do { _Pragma("unroll") for (int _i = 0; _i < 2; ++_i) \
        __builtin_amdgcn_global_load_lds((const unsigned*)((const char*)(gbase) + (voff)[_i]), (PG8_LAS unsigned*)(lds + (bufoff) + ldsw + _i * 8192), 16, 0, 0); } while (0)
#define PG8_LDA(dst, b, h) do { _Pragma("unroll") for (int m = 0; m < 4; ++m) _Pragma("unroll") for (int k = 0; k < 2; ++k) dst[m][k] = *(const PG8_LAS bf16x8*)(lds + PG8_SA(b, h) + aoff + m * 2048 + k * 1024); } while (0)
#define PG8_LDB(dst, b, h) do { _Pragma("unroll") for (int n = 0; n < 2; ++n) _Pragma("unroll") for (int k = 0; k < 2; ++k) dst[n][k] = *(const PG8_LAS bf16x8*)(lds + PG8_SB(b, h) + boff + n * 2048 + k * 1024); } while (0)
#define PG8_CAT8(x, y) __builtin_shufflevector(__builtin_bit_cast(i32x4_t, x), __builtin_bit_cast(i32x4_t, y), 0, 1, 2, 3, 4, 5, 6, 7)
#define PG8_MMA8(ai, bj, At, Bt) do { __builtin_amdgcn_s_setprio(1); { i32x8_t a8_[4], b8_[2]; _Pragma("unroll") for (int m = 0; m < 4; ++m) a8_[m] = PG8_CAT8(At[m][0], At[m][1]); _Pragma("unroll") for (int n = 0; n < 2; ++n) b8_[n] = PG8_CAT8(Bt[n][0], Bt[n][1]); \
        _Pragma("unroll") for (int m = 0; m < 4; ++m) _Pragma("unroll") for (int n = 0; n < 2; ++n) \
        asm volatile("v_mfma_scale_f32_16x16x128_f8f6f4 %0, %1, %2, %0, %3, %4 op_sel_hi:[0,0,0]" : "+v"(acc[ai][bj][m][n]) : "v"(b8_[n]), "v"(a8_[m]), "v"(sclB_), "v"(sclA_)); } __builtin_amdgcn_s_setprio(0); } while (0)
#define PG8_MMA16(ai, bj, At, Bt) do { __builtin_amdgcn_s_setprio(1); _Pragma("unroll") for (int m = 0; m < 4; ++m) _Pragma("unroll") for (int n = 0; n < 2; ++n) _Pragma("unroll") for (int k = 0; k < 2; ++k) \
        asm volatile("v_mfma_f32_16x16x32_bf16 %0, %1, %2, %0" : "+v"(acc[ai][bj][m][n]) : "v"(Bt[n][k]), "v"(At[m][k])); __builtin_amdgcn_s_setprio(0); } while (0)
#define PG8_WAIT_V(n) asm volatile("s_waitcnt vmcnt(" #n ")" ::: "memory")
#define PG8_WAIT_L(n) asm volatile("s_waitcnt lgkmcnt(" #n ")" ::: "memory")
#define PG8_BAR __builtin_amdgcn_s_barrier()
#define PG8_SCHED __builtin_amdgcn_sched_barrier(0)
#define PG8_BODY(MMA) do { \
            PG8_LDB(B0, 0, 0); PG8_LDB(B1, 0, 1); PG8_SCHED; PG8_LDA(At, 0, 0); PG8_STAGE(PG8_SA(1, 1), a1 + hstep, voffA); \
            PG8_WAIT_V(8); PG8_WAIT_L(0); PG8_BAR; MMA(0, 0, At, B0); MMA(0, 1, At, B1); PG8_BAR; PG8_SCHED; \
            PG8_LDA(At, 0, 1); PG8_STAGE(PG8_SB(0, 0), b2, voffB); PG8_STAGE(PG8_SB(0, 1), b2 + hstep, voffB); PG8_STAGE(PG8_SA(0, 0), a2, voffA); \
            PG8_WAIT_V(8); PG8_WAIT_L(0); PG8_BAR; MMA(1, 0, At, B0); MMA(1, 1, At, B1); PG8_BAR; PG8_SCHED; \
            PG8_LDB(B0, 1, 0); PG8_LDB(B1, 1, 1); PG8_SCHED; PG8_LDA(At, 1, 0); PG8_STAGE(PG8_SA(0, 1), a2 + hstep, voffA); \
            PG8_WAIT_V(8); PG8_WAIT_L(0); PG8_BAR; MMA(0, 0, At, B0); MMA(0, 1, At, B1); PG8_BAR; PG8_SCHED; \
            PG8_LDA(At, 1, 1); PG8_STAGE(PG8_SB(1, 0), b3, voffB); PG8_STAGE(PG8_SB(1, 1), b3 + hstep, voffB); PG8_STAGE(PG8_SA(1, 0), a3, voffA); \
            PG8_WAIT_V(8); PG8_WAIT_L(0); PG8_BAR; MMA(1, 0, At, B0); MMA(1, 1, At, B1); PG8_BAR; PG8_SCHED; } while (0)
    int sclA_ = 0x7F7F7F7F, sclB_ = SCALE_B; asm volatile("" : "+v"(sclA_), "+v"(sclB_));
    Unit cur, nxt; int ui = 0;
    if (!S.next(0, cur)) return;
    f32x4 acc[2][2][4][2];
#pragma unroll
    for (int a = 0; a < 2; ++a)
#pragma unroll
        for (int b = 0; b < 2; ++b)
#pragma unroll
            for (int m = 0; m < 4; ++m)
#pragma unroll
                for (int n = 0; n < 2; ++n) acc[a][b][m][n] = (f32x4){0.f, 0.f, 0.f, 0.f};
    bf16x8 At[4][2], B0[2][2], B1[2][2];
    const char* cA = (const char*)g.A + (size_t)cur.pm * tstep; const char* cB = (const char*)g.B + (size_t)cur.pn * tstep;
    PG8_STAGE(PG8_SB(0, 0), cB + O8, voffB); PG8_STAGE(PG8_SB(0, 1), cB + O8 + hstep, voffB); PG8_STAGE(PG8_SA(0, 0), cA + O8, voffA); PG8_STAGE(PG8_SA(0, 1), cA + O8 + hstep, voffA);
    if (wr == 1) PG8_BAR;
    PG8_WAIT_V(2); PG8_BAR;
    PG8_STAGE(PG8_SB(1, 0), cB + O8 + 128, voffB); PG8_STAGE(PG8_SA(1, 0), cA + O8 + 128, voffA); PG8_STAGE(PG8_SB(1, 1), cB + O8 + hstep + 128, voffB);
    PG8_WAIT_V(6); PG8_BAR;
    for (;;) {
        const bool has_next = S.next(ui + 1, nxt);
        const char* nA = has_next ? (const char*)g.A + (size_t)nxt.pm * tstep : cA; const char* nB = has_next ? (const char*)g.B + (size_t)nxt.pn * tstep : cB;
#pragma clang loop unroll(disable)
        for (int t = 0; t < n8; t += 2) {
            const char* a1 = cA + O8 + (size_t)(t + 1) * 128;
            const bool lastf = (t + 2 >= n8);
            const char* a2 = lastf ? cA : cA + O8 + (size_t)(t + 2) * 128; const char* b2 = lastf ? cB : cB + O8 + (size_t)(t + 2) * 128;
            const char* a3 = a2 + 128; const char* b3 = b2 + 128;
            PG8_BODY(PG8_MMA8);
        }
#pragma clang loop unroll(disable)
        for (int t = 0; t < n16; t += 2) {
            const char* a1 = cA + (size_t)(t + 1) * 128;
            const bool lastb = (t + 2 >= n16);
            const char* a2 = lastb ? nA + O8 : cA + (size_t)(t + 2) * 128; const char* b2 = lastb ? nB + O8 : cB + (size_t)(t + 2) * 128;
            const char* a3 = a2 + 128; const char* b3 = b2 + 128;
            PG8_BODY(PG8_MMA16);
        }
        asm volatile("s_nop 15\n\ts_nop 15" ::: "memory");
        if (wr == 0) PG8_BAR;
        E(acc, cur, wr, wc, fr, fq);
        if (!has_next) break;
#pragma unroll
        for (int a = 0; a < 2; ++a)
#pragma unroll
            for (int b = 0; b < 2; ++b)
#pragma unroll
                for (int m = 0; m < 4; ++m)
#pragma unroll
                    for (int n = 0; n < 2; ++n) acc[a][b][m][n] = (f32x4){0.f, 0.f, 0.f, 0.f};
        cur = nxt; cA = nA; cB = nB; ++ui;
        if (wr == 1) PG8_BAR;
    }
    PG8_WAIT_V(0);
    PG8_BAR;
#undef PG8_SA
#undef PG8_SB
#undef PG8_STAGE
#undef PG8_BODY
#undef PG8_MMA8
#undef PG8_MMA16
#undef PG8_LDA
#undef PG8_LDB
#undef PG8_CAT8
#undef PG8_WAIT_V
#undef PG8_WAIT_L
#undef PG8_BAR
#undef PG8_SCHED
}
}

constexpr int NB = 2, SEQ = 4096, DM = 4096, MROWS = NB * SEQ, HD = 128, NHB = 92, NPROJ = 12032, NIN = 11808, DFF = 16384, PLE = 256, DEPTH = 2;
constexpr int NCMP = 255;
constexpr float RMS_EPS = 1e-6f;
constexpr float QK_SCALE = 0.08838834764831845f;
constexpr int NWAVES = 8, NTHREADS = 512;
constexpr int HB_QA = 0, HB_KC = 8, HB_VC = 10, HB_KS = 12, HB_VS = 14, HB_KW = 16, HB_VW = 18, HB_QB = 20, HB_KB = 28, HB_VB = 36, HB_QC = 44, HB_KCC = 52, HB_VCC = 60, HB_QD = 68, HB_KD = 76, HB_VD = 84;
__host__ __device__ __forceinline__ bool hb_is_rope(int hb) { return hb < 8 || hb == 12 || hb == 13 || hb == 16 || hb == 17 || (hb >= 44 && hb < 60); }

constexpr size_t MiB = 1u << 20;
constexpr size_t WS_CTL = 0, CTL_ZERO_BYTES = 1 * MiB;
constexpr size_t WS_ROPE = 1 * MiB;
constexpr size_t WS_GATE = 6 * MiB;
constexpr size_t WS_CUM = 7 * MiB;
constexpr size_t WS_KC = 8 * MiB;
constexpr size_t WS_VC = 8 * MiB + 512 * 1024;
constexpr size_t WS_SSA = 12 * MiB, WS_SSB = 14 * MiB;
constexpr size_t WS_CBP = 11 * MiB;
constexpr size_t WS_HID = 10 * MiB;
constexpr size_t WS_SEL = 9 * MiB;
constexpr size_t WS_PB = 16 * MiB;
constexpr size_t WS_W = 32 * MiB;
constexpr size_t W_IN = 0, W_O = 94 * MiB, W_UP = 126 * MiB, W_DN = 254 * MiB, W_G = 382 * MiB, W_PP = 414 * MiB, W_C1K = 416 * MiB, W_C1V = 418 * MiB, W_C2K = 420 * MiB, W_C2V = 420 * MiB + 65536, LAYER_W = 424 * MiB;
constexpr size_t WS_XN = 896 * MiB;
constexpr size_t WS_QKV = 960 * MiB;
constexpr size_t WS_OCMP = 1144 * MiB;
constexpr size_t WS_MIX = 1176 * MiB;
constexpr int MIXLD = 6144, MIXO8 = 4096;
constexpr size_t WS_H = 1240 * MiB;
constexpr size_t WS_FF = 1368 * MiB;
constexpr size_t WS_XN8 = WS_FF;
constexpr size_t WS_PP = 1624 * MiB;
constexpr size_t WS_DO = 1688 * MiB;
constexpr size_t WS_LSE = 1784 * MiB;
constexpr size_t WS_OS = 1785 * MiB;
constexpr size_t WS_XN2 = 1817 * MiB;
constexpr size_t WS_END = 1881 * MiB;
static_assert(WS_W + 2 * LAYER_W <= WS_XN, "ws map");
static_assert((size_t)NPROJ * DM * 2 <= W_O, "ws map");
constexpr int N8P = 23, N16P = 24;
__constant__ unsigned char P8MAP[N8P] = {0,1,2,3,4,6,8,10,11,12,13,14,15,16,17,22,23,24,25,26,27,28,29};
__constant__ unsigned char P16MAP[N16P] = {5,7,9,18,19,20,21,30,31,32,33,34,35,36,37,38,39,40,41,42,43,44,45,46};
__constant__ unsigned char PTYPE[47] = {128,129,130,131,132,0,133,1,134,2,135,136,137,138,139,140,141,142,3,4,5,6,143,144,145,146,147,148,149,150,7,8,9,10,11,12,13,14,15,16,17,18,19,20,21,22,23};
constexpr size_t W_IN8 = 52 * MiB;
static_assert((size_t)N16P * 256 * 4096 * 2 <= W_IN8 && W_IN8 + (size_t)N8P * 256 * 4096 <= W_O, "w_in split");
constexpr int CW_BAR = 4096, CW_CBIAS = 16384;

constexpr int RING_OFF = 0, RING_BYTES = 131072;
constexpr int LDSCTL_OFF = RING_BYTES, MISC_OFF = LDSCTL_OFF + 320;
constexpr int LDS_BYTES = 147456;

#define GAS __attribute__((address_space(1)))
#define LAS __attribute__((address_space(3)))
typedef unsigned short bf16;
typedef unsigned v4u __attribute__((ext_vector_type(4)));
typedef unsigned v2u __attribute__((ext_vector_type(2)));
typedef float f32x4 __attribute__((ext_vector_type(4)));
typedef float f32x2 __attribute__((ext_vector_type(2)));
#define LDS_WAIT() asm volatile("s_waitcnt lgkmcnt(0)" ::: "memory")
#define VM_WAIT() asm volatile("s_waitcnt vmcnt(0)" ::: "memory")
__device__ __forceinline__ unsigned f2bf(float f) { unsigned u = __builtin_bit_cast(unsigned, f); return (u + 0x7fffu + ((u >> 16) & 1u)) >> 16; }
__device__ __forceinline__ unsigned pk2(float lo, float hi) { return f2bf(lo) | (f2bf(hi) << 16); }
__device__ __forceinline__ float bflo(unsigned u) { return __builtin_bit_cast(float, u << 16); }
__device__ __forceinline__ float bfhi(unsigned u) { return __builtin_bit_cast(float, u & 0xffff0000u); }
__device__ __forceinline__ unsigned pk4_fp8(float a, float b, float c, float d) { int v = __builtin_amdgcn_cvt_pk_fp8_f32(a, b, 0, false); v = __builtin_amdgcn_cvt_pk_fp8_f32(c, d, v, true); return (unsigned)v; }
__device__ __forceinline__ float wave_sum(float v) {
#pragma unroll
    for (int o = 1; o < 64; o <<= 1) v += __shfl_xor(v, o);
    return v;
}
__device__ __forceinline__ float wave_max(float v) {
#pragma unroll
    for (int o = 1; o < 64; o <<= 1) v = fmaxf(v, __shfl_xor(v, o));
    return v;
}
__device__ __forceinline__ float sigmoidf_(float x) { return 1.0f / (1.0f + __expf(-x)); }

#define XB_TMO      128
#define XB_XCNT(j)  (256  + 64 * (j))
#define XB_XSUB(j)  (1280 + 64 * (j))
#define XB_XGEN(j)  (2304 + 64 * (j))
#define XB_TOP      3328
#define XB_TOPGEN   3392
#define XCD_BAR_WORDS 3456
#define XB_SPIN_CAP (1u << 18)

__device__ __forceinline__ unsigned xb_ld(unsigned* p)              { return __hip_atomic_load(p, __ATOMIC_RELAXED, __HIP_MEMORY_SCOPE_AGENT); }
__device__ __forceinline__ unsigned xb_add(unsigned* p, unsigned v) { return __hip_atomic_fetch_add(p, v, __ATOMIC_RELAXED, __HIP_MEMORY_SCOPE_AGENT); }
__device__ __forceinline__ unsigned xb_xcc_id() { return (unsigned)__builtin_amdgcn_s_getreg((3 << 11) | 20) & 0xFu; }
#define XB_SPIN(cond, bar) do { unsigned _sp = 0; while (cond) { __builtin_amdgcn_s_sleep(1); \
    if ((++_sp & 255u) == 0u) { if (xb_ld(&(bar)[XB_TMO])) break; if (_sp > XB_SPIN_CAP) { atomicAdd(&(bar)[XB_TMO], 1u); break; } } } } while (0)

struct XcdBarrier {
    unsigned* bar; unsigned x;
    volatile LAS unsigned* st;
};

__device__ __forceinline__ XcdBarrier xcd_barrier_post(unsigned* bar, volatile LAS unsigned* st) {
    XcdBarrier b; b.bar = bar; b.x = xb_xcc_id(); b.st = st;
    if (threadIdx.x == 0) (void)xb_add(&bar[XB_XCNT(b.x)], 1u);
    return b;
}
__device__ __forceinline__ void xcd_barrier_complete(unsigned* bar, unsigned x, unsigned& nloc, unsigned& nx) {
    const unsigned G = gridDim.x * gridDim.y * gridDim.z;
    unsigned sum, cnt, mine, sp = 0u;
    for (;;) {
        sum = 0u; cnt = 0u; mine = 0u;
#pragma unroll
        for (unsigned j = 0; j < 16; ++j) { const unsigned c = xb_ld(&bar[XB_XCNT(j)]); sum += c; cnt += (c > 0u) ? 1u : 0u; mine = (j == x) ? c : mine; }
        if (sum == G) break;
        __builtin_amdgcn_s_sleep(1);
        if ((++sp & 255u) == 0u) { if (xb_ld(&bar[XB_TMO])) break; if (sp > XB_SPIN_CAP) { atomicAdd(&bar[XB_TMO], 1u); break; } }
    }
    nloc = mine > 0u ? mine : 1u; nx = cnt > 0u ? cnt : 1u;
}

__device__ __forceinline__ void xcd_barrier(const XcdBarrier& b) {
    asm volatile("s_waitcnt vmcnt(0)" ::: "memory");
    __syncthreads();
    if (threadIdx.x == 0) {
        unsigned* bar = b.bar;
        __builtin_amdgcn_s_waitcnt(0);
        unsigned nloc = b.st[0], nx = b.st[1];
        if (nloc == 0u) { xcd_barrier_complete(bar, b.x, nloc, nx); b.st[0] = nloc; b.st[1] = nx; }
        const unsigned old = xb_add(&bar[XB_XSUB(b.x)], 1u);
        const unsigned gen = old / nloc;
        if (old + 1u == (gen + 1u) * nloc) {
            __builtin_amdgcn_fence(__ATOMIC_RELEASE, "agent");
            asm volatile("s_waitcnt vmcnt(0)" ::: "memory");
            const unsigned og = xb_add(&bar[XB_TOP], 1u);
            const unsigned tg = og / nx;
            if (og + 1u == (tg + 1u) * nx) xb_add(&bar[XB_TOPGEN], 1u);
            else XB_SPIN(xb_ld(&bar[XB_TOPGEN]) == tg, bar);
            __builtin_amdgcn_fence(__ATOMIC_ACQUIRE, "agent");
            xb_add(&bar[XB_XGEN(b.x)], 1u);
            asm volatile("s_waitcnt vmcnt(0)" ::: "memory");
        } else {
            XB_SPIN(xb_ld(&bar[XB_XGEN(b.x)]) == gen, bar);
            __builtin_amdgcn_fence(__ATOMIC_ACQUIRE, "agent");
            asm volatile("s_waitcnt vmcnt(0)" ::: "memory");
        }
    }
    __syncthreads();
}

namespace pg8 {
__device__ __forceinline__ void row_rstd(const float* SS, int row0, int fq, float (&rs)[2][4]) {
#pragma unroll
    for (int ai = 0; ai < 2; ++ai)
#pragma unroll
        for (int m = 0; m < 4; ++m) { const f32x4* sp = (const f32x4*)(SS + (size_t)(row0 + ai * HALF + m * 16) * 64 + 16 * fq);
            const f32x4 a = sp[0], b = sp[1], c = sp[2], d = sp[3];
            float s = (((a[0] + a[1]) + (a[2] + a[3])) + ((b[0] + b[1]) + (b[2] + b[3]))) + (((c[0] + c[1]) + (c[2] + c[3])) + ((d[0] + d[1]) + (d[2] + d[3])));
            s += __shfl_xor(s, 16); s += __shfl_xor(s, 32);
            rs[ai][m] = 1.0f / sqrtf(s * (1.0f / 4096.0f) + 1e-6f); }
}
__device__ __forceinline__ float row_rstd1(const float* SS, int row, int fq) {
    const f32x4* sp = (const f32x4*)(SS + (size_t)row * 64 + 16 * fq);
    const f32x4 a = sp[0], b = sp[1], c = sp[2], d = sp[3];
    float s = (((a[0] + a[1]) + (a[2] + a[3])) + ((b[0] + b[1]) + (b[2] + b[3]))) + (((c[0] + c[1]) + (c[2] + c[3])) + ((d[0] + d[1]) + (d[2] + d[3])));
    s += __shfl_xor(s, 16); s += __shfl_xor(s, 32);
    return 1.0f / sqrtf(s * (1.0f / 4096.0f) + 1e-6f);
}
template <bool RSTD, bool P8> struct EpiProj {
    static constexpr bool PERM = true, AFTER_DRAIN = false, IDEMPOTENT = true;
    bf16_t* QKV; float* GATE; const float* cs; const PG8_LAS float* lr;
    __device__ __forceinline__ void operator()(const f32x4 (&acc)[2][2][4][2], const Unit& u, int wr, int wc, int fr, int fq) const {
        const int row0 = u.pm * BM + wr * 64 + fr;
        typedef unsigned u32x2 __attribute__((ext_vector_type(2)));
        const int pn_ = P8 ? P8MAP[u.pn] : P16MAP[u.pn];
        const bool gate = (pn_ == 46);
        const int hb0 = 2 * pn_; const bool rope0 = !gate && hb_is_rope(hb0), rope1 = !gate && hb_is_rope(hb0 + 1);
        const int e0 = 16 * wc + 4 * fq;
#pragma unroll
        for (int ai = 0; ai < 2; ++ai)
#pragma unroll
            for (int m = 0; m < 4; ++m) { const int row = row0 + ai * HALF + m * 16;
                const float rs = RSTD ? lr[u.idx * 256 + (row - u.pm * BM)] : 1.f;
                if (gate) { if (wc == 0) { float* gp = GATE + (size_t)row * 32 + 8 * fq; *(f32x4*)gp = acc[ai][0][m][0] * rs; *(f32x4*)(gp + 4) = acc[ai][0][m][1] * rs; } }
                else {
#pragma unroll
                    for (int bj = 0; bj < 2; ++bj) { bf16_t* base = QKV + (size_t)(hb0 + bj) * ((size_t)MROWS * HD) + (size_t)row * HD;
                        const f32x4 v0 = acc[ai][bj][m][0] * rs, v1 = acc[ai][bj][m][1] * rs;
                        if (bj == 0 ? rope0 : rope1) {
                            const f32x4 c = *(const f32x4*)(cs + (size_t)row * 64 + e0), s = *(const f32x4*)(cs + (size_t)MROWS * 64 + (size_t)row * 64 + e0);
                            const f32x4 o0 = v0 * c - v1 * s, o1 = v1 * c + v0 * s;
                            u32x2 w0, w1; w0.x = cvt_pk_bf16(o0[0], o0[1]); w0.y = cvt_pk_bf16(o0[2], o0[3]); w1.x = cvt_pk_bf16(o1[0], o1[1]); w1.y = cvt_pk_bf16(o1[2], o1[3]);
                            *(u32x2*)(base + e0) = w0; *(u32x2*)(base + e0 + 64) = w1;
                        } else {
                            u32x4 w; w.x = cvt_pk_bf16(v0[0], v0[1]); w.y = cvt_pk_bf16(v0[2], v0[3]); w.z = cvt_pk_bf16(v1[0], v1[1]); w.w = cvt_pk_bf16(v1[2], v1[3]);
                            *(u32x4*)(base + wc * 32 + 8 * fq) = w; } } }
                if (m & 1) asm volatile("" ::: "memory"); }
    }
};
template <bool SRC32, bool F8OUT> struct EpiResid {
    static constexpr bool PERM = true, AFTER_DRAIN = false, IDEMPOTENT = false;
    const void* src; bf16_t* dst; int ldc; unsigned char* XN8; float* SS;
    __device__ __forceinline__ void operator()(const f32x4 (&acc)[2][2][4][2], const Unit& u, int wr, int wc, int fr, int fq) const {
        const int row0 = u.pm * BM + wr * 64 + fr, col0 = u.pn * BM + wc * 32 + 8 * fq;
#pragma unroll
        for (int ai = 0; ai < 2; ++ai)
#pragma unroll
            for (int m = 0; m < 4; ++m) { const int row = row0 + ai * HALF + m * 16; const size_t off = (size_t)row * ldc + col0; float ss = 0.f;
#pragma unroll
                for (int bj = 0; bj < 2; ++bj) { f32x4 s0, s1;
                    if (SRC32) { const float* sp = (const float*)src + off + bj * HALF; s0 = *(const f32x4*)sp; s1 = *(const f32x4*)(sp + 4); }
                    else { const u32x4 sw = *(const u32x4*)((const bf16_t*)src + off + bj * HALF);
                        s0 = f32x4{__builtin_bit_cast(float, sw.x << 16), __builtin_bit_cast(float, sw.x & 0xffff0000u), __builtin_bit_cast(float, sw.y << 16), __builtin_bit_cast(float, sw.y & 0xffff0000u)};
                        s1 = f32x4{__builtin_bit_cast(float, sw.z << 16), __builtin_bit_cast(float, sw.z & 0xffff0000u), __builtin_bit_cast(float, sw.w << 16), __builtin_bit_cast(float, sw.w & 0xffff0000u)}; }
                    const f32x4 o0 = s0 + acc[ai][bj][m][0], o1 = s1 + acc[ai][bj][m][1];
                    u32x4 w; w.x = cvt_pk_bf16(o0[0], o0[1]); w.y = cvt_pk_bf16(o0[2], o0[3]); w.z = cvt_pk_bf16(o1[0], o1[1]); w.w = cvt_pk_bf16(o1[2], o1[3]);
                    *(u32x4*)(dst + off + bj * HALF) = w;
                    ss += ((o0[0] * o0[0] + o0[1] * o0[1]) + (o0[2] * o0[2] + o0[3] * o0[3])) + ((o1[0] * o1[0] + o1[1] * o1[1]) + (o1[2] * o1[2] + o1[3] * o1[3]));
                    if (F8OUT) { typedef unsigned u32x2 __attribute__((ext_vector_type(2))); u32x2 w8; w8.x = pk4_fp8(o0[0], o0[1], o0[2], o0[3]); w8.y = pk4_fp8(o1[0], o1[1], o1[2], o1[3]);
                        *(u32x2*)(XN8 + off + bj * HALF) = w8; } }
                ss += __shfl_xor(ss, 16); ss += __shfl_xor(ss, 32);
                if (fq == 0) SS[(size_t)row * 64 + u.pn * 4 + wc] = ss; }
    }
};
template <int ACT> struct EpiAct {
    static constexpr bool PERM = true, AFTER_DRAIN = false, IDEMPOTENT = true;
    bf16_t* O; int ldc; const PG8_LAS float* lr;
    __device__ __forceinline__ void operator()(const f32x4 (&acc)[2][2][4][2], const Unit& u, int wr, int wc, int fr, int fq) const {
        const int row0 = u.pm * BM + wr * 64 + fr, col0 = u.pn * BM + wc * 32 + 8 * fq;
        float rs[2][4];
        if (ACT == 2) {
#pragma unroll
            for (int ai = 0; ai < 2; ++ai)
#pragma unroll
                for (int m = 0; m < 4; ++m) rs[ai][m] = lr[u.idx * 256 + wr * 64 + fr + ai * HALF + m * 16]; }
#pragma unroll
        for (int ai = 0; ai < 2; ++ai)
#pragma unroll
            for (int m = 0; m < 4; ++m) { bf16_t* rowp = O + (size_t)(row0 + ai * HALF + m * 16) * ldc + col0;
#pragma unroll
                for (int bj = 0; bj < 2; ++bj) { f32x4 v0 = acc[ai][bj][m][0], v1 = acc[ai][bj][m][1];
                    if (ACT == 2) { const f32x4 z = {0.f, 0.f, 0.f, 0.f}; v0 = __builtin_elementwise_max(v0, z) * rs[ai][m]; v1 = __builtin_elementwise_max(v1, z) * rs[ai][m]; v0 = v0 * v0; v1 = v1 * v1; }
                    u32x4 w; w.x = cvt_pk_bf16(v0[0], v0[1]); w.y = cvt_pk_bf16(v0[2], v0[3]); w.z = cvt_pk_bf16(v1[0], v1[1]); w.w = cvt_pk_bf16(v1[2], v1[3]);
                    *(u32x4*)(rowp + bj * HALF) = w; } }
    }
};
template <bool NEXT> struct EpiPle {
    static constexpr bool PERM = true, AFTER_DRAIN = false, IDEMPOTENT = false;
    bf16_t* H; const bf16_t* PP; int ldc; const PG8_LAS float* lr; float* SSout; unsigned char* XN8;
    __device__ __forceinline__ void operator()(const f32x4 (&acc)[2][2][4][2], const Unit& u, int wr, int wc, int fr, int fq) const {
        const int row0 = u.pm * BM + wr * 64 + fr, col0 = u.pn * BM + wc * 32 + 8 * fq;
        float rs[2][4];
#pragma unroll
        for (int ai = 0; ai < 2; ++ai)
#pragma unroll
            for (int m = 0; m < 4; ++m) rs[ai][m] = lr[u.idx * 256 + wr * 64 + fr + ai * HALF + m * 16];
#pragma unroll
        for (int ai = 0; ai < 2; ++ai)
#pragma unroll
            for (int m = 0; m < 4; ++m) { const int row = row0 + ai * HALF + m * 16; const size_t off = (size_t)row * ldc + col0; float ss = 0.f;
#pragma unroll
                for (int bj = 0; bj < 2; ++bj) { const f32x4 v0 = acc[ai][bj][m][0] * rs[ai][m], v1 = acc[ai][bj][m][1] * rs[ai][m];
                    const u32x4 pw = *(const u32x4*)(PP + off + bj * HALF); const u32x4 hw = *(const u32x4*)(H + off + bj * HALF);
                    f32x4 p0 = {__builtin_bit_cast(float, pw.x << 16), __builtin_bit_cast(float, pw.x & 0xffff0000u), __builtin_bit_cast(float, pw.y << 16), __builtin_bit_cast(float, pw.y & 0xffff0000u)};
                    f32x4 p1 = {__builtin_bit_cast(float, pw.z << 16), __builtin_bit_cast(float, pw.z & 0xffff0000u), __builtin_bit_cast(float, pw.w << 16), __builtin_bit_cast(float, pw.w & 0xffff0000u)};
                    f32x4 h0 = {__builtin_bit_cast(float, hw.x << 16), __builtin_bit_cast(float, hw.x & 0xffff0000u), __builtin_bit_cast(float, hw.y << 16), __builtin_bit_cast(float, hw.y & 0xffff0000u)};
                    f32x4 h1 = {__builtin_bit_cast(float, hw.z << 16), __builtin_bit_cast(float, hw.z & 0xffff0000u), __builtin_bit_cast(float, hw.w << 16), __builtin_bit_cast(float, hw.w & 0xffff0000u)};
#pragma unroll
                    for (int i = 0; i < 4; ++i) { h0[i] += p0[i] * __builtin_amdgcn_rcpf(1.0f + __expf(-v0[i])); h1[i] += p1[i] * __builtin_amdgcn_rcpf(1.0f + __expf(-v1[i])); }
                    u32x4 w; w.x = cvt_pk_bf16(h0[0], h0[1]); w.y = cvt_pk_bf16(h0[2], h0[3]); w.z = cvt_pk_bf16(h1[0], h1[1]); w.w = cvt_pk_bf16(h1[2], h1[3]);
                    *(u32x4*)(H + off + bj * HALF) = w;
                    if (NEXT) { ss += ((h0[0] * h0[0] + h0[1] * h0[1]) + (h0[2] * h0[2] + h0[3] * h0[3])) + ((h1[0] * h1[0] + h1[1] * h1[1]) + (h1[2] * h1[2] + h1[3] * h1[3]));
                        typedef unsigned u32x2 __attribute__((ext_vector_type(2))); u32x2 w8; w8.x = pk4_fp8(h0[0], h0[1], h0[2], h0[3]); w8.y = pk4_fp8(h1[0], h1[1], h1[2], h1[3]); *(u32x2*)(XN8 + off + bj * HALF) = w8; } }
                if (NEXT) { ss += __shfl_xor(ss, 16); ss += __shfl_xor(ss, 32); if (fq == 0) SSout[(size_t)row * 64 + u.pn * 4 + wc] = ss; } }
    }
};
}

constexpr int PH_PER_LAYER = 7, NPH = 2 + 2 * PH_PER_LAYER;

constexpr int LRSTD_OFF = LDSCTL_OFF + 2048;
template <class Sched>
__device__ __forceinline__ void rstd_prepass(LAS unsigned char* lds, const Sched& S, const float* SS) {
    int tid_ = threadIdx.x; asm volatile("" : "+v"(tid_));
    const int tid = tid_, r = tid >> 1, half = tid & 1;
    LAS float* lr = (LAS float*)(lds + LRSTD_OFF);
    pg8::Unit u;
    for (int i = 0; i < 8 && S.next(i, u); ++i) {
        const f32x4* sp = (const f32x4*)(SS + (size_t)(u.pm * 256 + r) * 64 + 32 * half);
        f32x4 v[8];
#pragma unroll
        for (int k = 0; k < 8; ++k) v[k] = sp[k];
        float s = 0.f;
#pragma unroll
        for (int k = 0; k < 8; ++k) s += (v[k][0] + v[k][1]) + (v[k][2] + v[k][3]);
        s += __shfl_xor(s, 1);
        if (half == 0) lr[i * 256 + r] = 1.0f / sqrtf(s * (1.0f / 4096.0f) + 1e-6f);
    }
    __syncthreads();
}
struct Params { const void* in[20]; float* out; unsigned char* ws; int ph_lo, ph_hi; };
enum { I_X = 0, I_P, I_POS, I_NATT, I_WIN, I_FOXB, I_PEK, I_W1K, I_W2K, I_PEV, I_W1V, I_W2V, I_WO, I_NMLP, I_WUP, I_WDN, I_NPLE, I_WG, I_WPP, I_NFIN };

template <bool F32OUT, bool SRC16 = false>
__device__ __forceinline__ void norm_phase(const float* src, const float* g, void* dst, int gw, int NGW, int lane, unsigned char* dst8 = nullptr) {
    for (int row = gw; row < MROWS; row += NGW) {
        const f32x4* xr = (const f32x4*)(src + (size_t)row * DM) + lane;
        f32x4 v[16]; float ss = 0.f;
#pragma unroll
        for (int j = 0; j < 16; ++j) { if (SRC16) { const v2u hw = *((const v2u*)((const bf16*)src + (size_t)row * DM) + lane + 64 * j); v[j] = f32x4{bflo(hw.x), bfhi(hw.x), bflo(hw.y), bfhi(hw.y)}; } else v[j] = xr[64 * j]; ss += (v[j][0] * v[j][0] + v[j][1] * v[j][1]) + (v[j][2] * v[j][2] + v[j][3] * v[j][3]); }
        const float rstd = 1.0f / sqrtf(wave_sum(ss) * (1.0f / DM) + RMS_EPS);
#pragma unroll
        for (int j = 0; j < 16; ++j) { const f32x4 one = {1.f, 1.f, 1.f, 1.f}; const f32x4 gg = g ? *((const f32x4*)g + lane + 64 * j) : one; const f32x4 o = v[j] * rstd * gg;
            if (F32OUT) *((f32x4*)((float*)dst + (size_t)row * DM) + lane + 64 * j) = o;
            else { v2u w; w.x = pk2(o[0], o[1]); w.y = pk2(o[2], o[3]); *((v2u*)((bf16*)dst + (size_t)row * DM) + lane + 64 * j) = w;
                if (dst8) *((unsigned*)(dst8 + (size_t)row * DM) + lane + 64 * j) = pk4_fp8(o[0], o[1], o[2], o[3]); } }
    }
}

__device__ __forceinline__ int win_rowmap(int n) {
    int c;
    if (n < 2560) c = n; else if (n < 2584) c = 11776 + (n - 2560); else if (n < 5656) c = n - 24; else if (n < 5664) c = 11776 + 24 + (n - 5656); else c = n - 32;
    if (c < 11776) { const int hb = c >> 7; if (hb_is_rope(hb)) { const int d = c & 127, e = d & 63, nn = d >> 6; c = (hb << 7) + 32 * (e >> 4) + 8 * ((e >> 2) & 3) + 4 * nn + (e & 3); } }
    return c;
}
template <bool WINMAP, bool F8 = false, bool WOSPLIT = false>
__device__ __forceinline__ void p0_transpose_item(const float* W, int K, int N, bf16* WT, LAS float* scr, int item, int lane, const float* gk = nullptr) {
    const int nblk = N / 32, kb = item / nblk, nb = item % nblk, k0 = 64 * kb, n0 = 32 * nb;
#pragma unroll 8
    for (int i = 0; i < 32; ++i) { const int kk = 2 * i + (lane >> 5); scr[kk * 33 + (lane & 31)] = __builtin_nontemporal_load(W + (size_t)(k0 + kk) * N + n0 + (lane & 31)); }
    LDS_WAIT(); asm volatile("" ::: "memory");
    const int c = lane & 7;
    f32x4 ga = {1.f, 1.f, 1.f, 1.f}, gb = ga;
    if (gk) { ga = *(const f32x4*)(gk + k0 + 8 * c); gb = *(const f32x4*)(gk + k0 + 8 * c + 4); }
#pragma unroll
    for (int j = 0; j < 4; ++j) { const int n = (lane >> 3) + 8 * j; const LAS float* s = scr + (8 * c) * 33 + n;
        const float e0 = s[0 * 33] * ga[0], e1 = s[1 * 33] * ga[1], e2 = s[2 * 33] * ga[2], e3 = s[3 * 33] * ga[3], e4 = s[4 * 33] * gb[0], e5 = s[5 * 33] * gb[1], e6 = s[6 * 33] * gb[2], e7 = s[7 * 33] * gb[3];
        v4u o; o.x = pk2(e0, e1); o.y = pk2(e2, e3); o.z = pk2(e4, e5); o.w = pk2(e6, e7);
        const int nr = WINMAP ? win_rowmap(n0 + n) : (n0 + n);
        if (WINMAP) { const unsigned code = PTYPE[nr >> 8]; const size_t rr = (size_t)(((code & 127u) << 8) + (nr & 255));
            if (code & 128u) { v2u o8; o8.x = pk4_fp8(e0 * 64.f, e1 * 64.f, e2 * 64.f, e3 * 64.f); o8.y = pk4_fp8(e4 * 64.f, e5 * 64.f, e6 * 64.f, e7 * 64.f);
                __builtin_nontemporal_store(o8, (GAS v2u*)((unsigned char*)WT + W_IN8 + rr * K + k0 + 8 * c)); }
            else __builtin_nontemporal_store(o, (GAS v4u*)(WT + rr * K + k0 + 8 * c)); }
        else if (WOSPLIT) { const int seg_ = k0 >> 10, kk0_ = (k0 & 1023) + (seg_ >= 2 ? 1024 : 0);
            if ((seg_ & 1) == 0) { v2u o8; o8.x = pk4_fp8(e0 * 64.f, e1 * 64.f, e2 * 64.f, e3 * 64.f); o8.y = pk4_fp8(e4 * 64.f, e5 * 64.f, e6 * 64.f, e7 * 64.f);
                __builtin_nontemporal_store(o8, (GAS v2u*)((unsigned char*)WT + (size_t)nr * MIXLD + MIXO8 + kk0_ + 8 * c)); }
            else __builtin_nontemporal_store(o, (GAS v4u*)(WT + (size_t)nr * (MIXLD / 2) + kk0_ + 8 * c)); }
        else if (F8) { v2u o8; o8.x = pk4_fp8(e0 * 64.f, e1 * 64.f, e2 * 64.f, e3 * 64.f); o8.y = pk4_fp8(e4 * 64.f, e5 * 64.f, e6 * 64.f, e7 * 64.f);
            __builtin_nontemporal_store(o8, (GAS v2u*)((unsigned char*)WT + (size_t)nr * K + k0 + 8 * c)); }
        else __builtin_nontemporal_store(o, (GAS v4u*)(WT + (size_t)nr * K + k0 + 8 * c)); }
    LDS_WAIT(); asm volatile("" ::: "memory");
}

__device__ __forceinline__ void prologue_phase(const Params& P, LAS unsigned char* lds, int gw, int NGW, int wave, int lane, int rep = 0) {
    LAS float* scr = (LAS float*)(lds + RING_OFF + wave * 16384);
    unsigned char* ws = P.ws;
    constexpr int I_IN = (DM / 64) * (NIN / 32), I_O = (DM / 64) * (DM / 32), I_UP = (DM / 64) * (DFF / 32), I_DN = (DFF / 64) * (DM / 32), I_G = I_O, I_PPJ = (PLE / 64) * (DM / 32), I_C1 = (4096 / 64) * (256 / 32), I_C2 = (256 / 64) * (128 / 32);
    constexpr int PER_LAYER = I_IN + I_O + I_UP + I_DN + I_G + I_PPJ + 2 * I_C1 + 2 * I_C2;
    for (int it = gw; it < 2 * PER_LAYER; it += NGW) {
        const int l = it >= PER_LAYER ? 1 : 0; int r = it - l * PER_LAYER;
        unsigned char* wl = ws + WS_W + (size_t)l * LAYER_W;
        if (r < I_IN) { p0_transpose_item<true>((const float*)P.in[I_WIN] + (size_t)l * DM * NIN, DM, NIN, (bf16*)(wl + W_IN), scr, r, lane, (const float*)P.in[I_NATT] + (size_t)l * DM); continue; } r -= I_IN;
        if (r < I_O) { p0_transpose_item<false, false, true>((const float*)P.in[I_WO] + (size_t)l * DM * DM, DM, DM, (bf16*)(wl + W_O), scr, r, lane); continue; } r -= I_O;
        if (r < I_UP) { p0_transpose_item<false>((const float*)P.in[I_WUP] + (size_t)l * DM * DFF, DM, DFF, (bf16*)(wl + W_UP), scr, r, lane, (const float*)P.in[I_NMLP] + (size_t)l * DM); continue; } r -= I_UP;
        if (r < I_DN) { p0_transpose_item<false>((const float*)P.in[I_WDN] + (size_t)l * DFF * DM, DFF, DM, (bf16*)(wl + W_DN), scr, r, lane); continue; } r -= I_DN;
        if (r < I_G) { p0_transpose_item<false, true>((const float*)P.in[I_WG] + (size_t)l * DM * DM, DM, DM, (bf16*)(wl + W_G), scr, r, lane, (const float*)P.in[I_NPLE] + (size_t)l * DM); continue; } r -= I_G;
        if (r < I_PPJ) { p0_transpose_item<false>((const float*)P.in[I_WPP] + (size_t)l * PLE * DM, PLE, DM, (bf16*)(wl + W_PP), scr, r, lane); continue; } r -= I_PPJ;
        if (r < I_C1) { p0_transpose_item<false>((const float*)P.in[I_W1K] + (size_t)l * 4096 * 256, 4096, 256, (bf16*)(wl + W_C1K), scr, r, lane); continue; } r -= I_C1;
        if (r < I_C1) { p0_transpose_item<false>((const float*)P.in[I_W1V] + (size_t)l * 4096 * 256, 4096, 256, (bf16*)(wl + W_C1V), scr, r, lane); continue; } r -= I_C1;
        if (r < I_C2) { p0_transpose_item<false>((const float*)P.in[I_W2K] + (size_t)l * 256 * 128, 256, 128, (bf16*)(wl + W_C2K), scr, r, lane); continue; } r -= I_C2;
        p0_transpose_item<false>((const float*)P.in[I_W2V] + (size_t)l * 256 * 128, 256, 128, (bf16*)(wl + W_C2V), scr, r, lane);
    }
    if (gw < 256) {
        const int lkv = gw >> 6, kc = gw & 63, l = lkv >> 1, kv = lkv & 1;
        const float* pe = (const float*)P.in[kv ? I_PEV : I_PEK] + (size_t)l * 4096; const float* w1 = (const float*)P.in[kv ? I_W1V : I_W1K] + (size_t)l * 4096 * 256;
        f32x4 acc = {0.f, 0.f, 0.f, 0.f};
#pragma unroll 8
        for (int kk = 0; kk < 64; ++kk) { const int k = 64 * kc + kk; acc += pe[k] * *(const f32x4*)(w1 + (size_t)k * 256 + 4 * lane); }
        *(f32x4*)((float*)(ws + WS_CBP) + (size_t)(lkv * 64 + kc) * 256 + 4 * lane) = acc;
    }
    { const float* p = (const float*)P.in[I_P]; bf16* pb = (bf16*)(ws + WS_PB); const int n4 = DEPTH * MROWS * PLE / 4;
      for (int i = gw * 64 + lane; i < n4; i += NGW * 64) { const f32x4 v = *(const f32x4*)(p + (size_t)i * 4); v2u o; o.x = pk2(v[0], v[1]); o.y = pk2(v[2], v[3]); *(v2u*)(pb + (size_t)i * 4) = o; } }
    norm_phase<false>((const float*)P.in[I_X], nullptr, (bf16*)(ws + WS_XN), gw, NGW, lane, ws + WS_XN8);
    { const int* pos = (const int*)P.in[I_POS]; float* cs = (float*)(ws + WS_ROPE);
      for (int i = gw * 64 + lane; i < MROWS * 64; i += NGW * 64) { const int row = i >> 6, e = i & 63;
          const double inv = exp(-9.210340371976184 * (double)e / 64.0), a = (double)pos[row] * inv; double sn, cn; sincos(a, &sn, &cn);
          cs[i] = (float)cn; cs[(size_t)MROWS * 64 + i] = (float)sn; } }
}

__device__ __forceinline__ float gelu_tanh(float x) { const float u = 0.7978845608028654f * (x + 0.044715f * x * x * x); return 0.5f * x * (1.0f + tanhf(u)); }
__device__ __forceinline__ float log_sigmoid_f(float x) { return fminf(x, 0.f) - log1pf(expf(-fabsf(x))); }

__device__ __forceinline__ const bf16* head_ptr(const bf16* QKV, int hb, int b) { return QKV + (size_t)(hb * NB + b) * SEQ * HD; }
namespace fa {
typedef short bf16x8 __attribute__((ext_vector_type(8)));
typedef short s16x4 __attribute__((ext_vector_type(4)));
typedef float f32x16 __attribute__((ext_vector_type(16)));
typedef unsigned u32x4 __attribute__((ext_vector_type(4)));
constexpr int KVBLK = 64, SHM = 16384;
constexpr int L_V = 0, L_K = 2 * SHM, L_BIAS = 4 * SHM, L_WS = L_BIAS + 512, L_MISC = L_WS + 8 * 256, L_END = L_MISC + 256;
constexpr float SCALE = 0.08838834764831845f, C2 = 1.4426950408889634f * SCALE, THR = 8.f;
#define FA_KSWZ(row, colB) ((row) * 256 + ((colB) ^ (((row) & 7) << 4)))
#define FA_SBAR() __builtin_amdgcn_sched_barrier(0)
__device__ __forceinline__ int v_st(int k, int c) { const int kk = (k & ~0xC) | ((k & 4) << 1) | ((k & 8) >> 1); return ((kk >> 3) * 4 + (c >> 5)) * 512 + ((kk & 7) * 32 + (c & 31)) * 2; }
__device__ __forceinline__ int v_rd_base(int lane) { return ((lane & 3) << 3) | (((lane >> 2) & 3) << 6) | (((lane >> 4) & 1) << 5) | (((lane >> 5) & 1) << 8); }
constexpr int v_rd_off(int d0, int ks, int half) { return d0 * 512 + ks * 4096 + half * 2048; }
__device__ __forceinline__ int crow(int r, int hi) { return (r & 3) + 8 * (r >> 2) + 4 * hi; }
__device__ __forceinline__ unsigned cvtpk(float lo, float hi) { unsigned r; asm volatile("v_cvt_pk_bf16_f32 %0, %1, %2" : "=v"(r) : "v"(lo), "v"(hi)); return r; }

__device__ __forceinline__ void mask_tile(f32x16& p0, f32x16& p1, int dq, unsigned W) {
    const float NEG = -__builtin_inff();
#pragma unroll
    for (int r = 0; r < 16; ++r) { const int c = (r & 3) + 8 * (r >> 2);
        if ((unsigned)(dq - c) >= W) p0[r] = NEG;
        if ((unsigned)(dq - c - 32) >= W) p1[r] = NEG; }
}
__device__ __forceinline__ void partialSM(f32x16& p0, f32x16& p1, float& m_reg, float& mn, float& alpha) {
    float pmax = p0[0];
#pragma unroll
    for (int r = 1; r < 16; ++r) pmax = fmaxf(pmax, p0[r]);
#pragma unroll
    for (int r = 0; r < 16; ++r) pmax = fmaxf(pmax, p1[r]);
    { auto rr = __builtin_amdgcn_permlane32_swap(__float_as_uint(pmax), __float_as_uint(pmax), false, false);
      pmax = fmaxf(__uint_as_float(rr[0]), __uint_as_float(rr[1])); }
    if (__builtin_expect(__all((pmax - m_reg) * SCALE <= THR), 1)) { mn = m_reg; alpha = 1.f; }
    else { mn = fmaxf(m_reg, pmax); alpha = __builtin_amdgcn_exp2f((m_reg - mn) * C2); m_reg = mn; }
    const float mnL = -mn * C2;
#pragma unroll
    for (int r = 0; r < 16; ++r) p0[r] = __builtin_amdgcn_exp2f(fmaf(p0[r], C2, mnL));
#pragma unroll
    for (int r = 0; r < 16; ++r) p1[r] = __builtin_amdgcn_exp2f(fmaf(p1[r], C2, mnL));
}
#define FA_PK4(P, B_, OUT) do { unsigned a0 = cvtpk(P[B_+0], P[B_+1]), a1 = cvtpk(P[B_+2], P[B_+3]); unsigned b0 = cvtpk(P[B_+4], P[B_+5]), b1 = cvtpk(P[B_+6], P[B_+7]); \
        auto r0 = __builtin_amdgcn_permlane32_swap(a0, b0, false, false); auto r1 = __builtin_amdgcn_permlane32_swap(a1, b1, false, false); \
        u32x4 w = {r0[0], r1[0], r0[1], r1[1]}; OUT = __builtin_bit_cast(bf16x8, w); } while (0)
__device__ __forceinline__ void finishSM(f32x16& p0, f32x16& p1, float alpha, float& l_reg, bf16x8& pa0, bf16x8& pa1, bf16x8& pa2, bf16x8& pa3) {
    float ps = 0;
#pragma unroll
    for (int r = 0; r < 16; ++r) ps += p0[r];
#pragma unroll
    for (int r = 0; r < 16; ++r) ps += p1[r];
    { auto rr = __builtin_amdgcn_permlane32_swap(__float_as_uint(ps), __float_as_uint(ps), false, false); ps = __uint_as_float(rr[0]) + __uint_as_float(rr[1]); }
    l_reg = l_reg * alpha + ps;
    FA_PK4(p0, 0, pa0); FA_PK4(p0, 8, pa1); FA_PK4(p1, 0, pa2); FA_PK4(p1, 8, pa3);
}
template <int KB>
__device__ __forceinline__ void qkt(f32x16& p0, f32x16& p1, const LAS char* lds, int r32, int hi, const bf16x8* qr) {
    p0 = f32x16{}; p1 = f32x16{};
    const LAS char* kb[4];
#pragma unroll
    for (int dd = 0; dd < 4; ++dd) kb[dd] = lds + L_K + KB * SHM + FA_KSWZ(r32, (dd * 16 + hi * 8) * 2);
#pragma unroll
    for (int d0 = 0; d0 < 8; ++d0) { const LAS char* a = kb[d0 & 3] + (d0 >> 2) * 128;
        const bf16x8 b0 = *(const LAS bf16x8*)a, b1 = *(const LAS bf16x8*)(a + 32 * 256);
        p0 = __builtin_amdgcn_mfma_f32_32x32x16_bf16(b0, qr[d0], p0, 0, 0, 0);
        p1 = __builtin_amdgcn_mfma_f32_32x32x16_bf16(b1, qr[d0], p1, 0, 0, 0); }
}
template <int VB>
__device__ __forceinline__ void pv_tile(f32x16* o, int vb0, bf16x8 pa0, bf16x8 pa1, bf16x8 pa2, bf16x8 pa3) {
#define FA_TRRD(dst, off) asm volatile("ds_read_b64_tr_b16 %0, %1 offset:%2" : "=&v"(dst) : "v"(vb0), "i"(off) : "memory")
#define FA_PV_D0(d0) do { s16x4 l0, l1, l2, l3, h0, h1, h2, h3; constexpr int b_ = L_V + VB * SHM + v_rd_off(d0, 0, 0); \
        FA_TRRD(l0, b_); FA_TRRD(h0, b_ + 2048); FA_TRRD(l1, b_ + 4096); FA_TRRD(h1, b_ + 6144); FA_TRRD(l2, b_ + 8192); FA_TRRD(h2, b_ + 10240); FA_TRRD(l3, b_ + 12288); FA_TRRD(h3, b_ + 14336); \
        asm volatile("s_waitcnt lgkmcnt(0)" ::: "memory"); FA_SBAR(); \
        o[d0] = __builtin_amdgcn_mfma_f32_32x32x16_bf16(pa0, (bf16x8){l0[0], l0[1], l0[2], l0[3], h0[0], h0[1], h0[2], h0[3]}, o[d0], 0, 0, 0); \
        o[d0] = __builtin_amdgcn_mfma_f32_32x32x16_bf16(pa1, (bf16x8){l1[0], l1[1], l1[2], l1[3], h1[0], h1[1], h1[2], h1[3]}, o[d0], 0, 0, 0); \
        o[d0] = __builtin_amdgcn_mfma_f32_32x32x16_bf16(pa2, (bf16x8){l2[0], l2[1], l2[2], l2[3], h2[0], h2[1], h2[2], h2[3]}, o[d0], 0, 0, 0); \
        o[d0] = __builtin_amdgcn_mfma_f32_32x32x16_bf16(pa3, (bf16x8){l3[0], l3[1], l3[2], l3[3], h3[0], h3[1], h3[2], h3[3]}, o[d0], 0, 0, 0); } while (0)
    FA_PV_D0(0); FA_PV_D0(1); FA_PV_D0(2); FA_PV_D0(3);
#undef FA_PV_D0
#undef FA_TRRD
}

struct Blk {
    const bf16* Q; int qstride;
    const bf16* K; const bf16* V; int kvstride;
    int qpos;
    int j_lo, j_hi;
};
struct Extra { const float* cum; float cref; unsigned mlo, mhi; int W; };

struct Stage { bf16x8 k0, k1, v0, v1; f32x4 cb; };
template <int MODE>
__device__ __forceinline__ void stage_load(Stage& S, const Blk& B, const Extra& X, int j, int sr, int sc, int tid) {
    const size_t r0 = (size_t)(j * KVBLK + sr) * B.kvstride + sc, r1 = r0 + (size_t)32 * B.kvstride;
    S.v0 = *(const bf16x8*)(B.V + r0); S.v1 = *(const bf16x8*)(B.V + r1);
    S.k0 = *(const bf16x8*)(B.K + r0); S.k1 = *(const bf16x8*)(B.K + r1);
    if (MODE == 0) { if (tid < 16) S.cb = *(const f32x4*)(X.cum + j * KVBLK + tid * 4); }
}
template <int MODE>
__device__ __forceinline__ void stage_write(const Stage& S, LAS char* lds, int buf, int kws, int vst0, int vst1, float cref, int tid) {
    *(LAS bf16x8*)(lds + L_V + buf * SHM + vst0) = S.v0; *(LAS bf16x8*)(lds + L_V + buf * SHM + vst1) = S.v1;
    *(LAS bf16x8*)(lds + L_K + buf * SHM + kws) = S.k0; *(LAS bf16x8*)(lds + L_K + buf * SHM + kws + 32 * 256) = S.k1;
    if (MODE == 0) { if (tid < 16) { const float is = 11.313708498984761f; f32x4 b = {(cref - S.cb[0]) * is, (cref - S.cb[1]) * is, (cref - S.cb[2]) * is, (cref - S.cb[3]) * is};
        *(LAS f32x4*)(lds + L_BIAS + buf * 256 + tid * 16) = b; } }
}

template <int MODE>
__device__ __forceinline__ void softmax_block(LAS char* lds, const Blk& B, const Extra& X, f32x16 (&o)[4], float& m_reg, float& l_reg) {
    int tid_ = threadIdx.x; asm volatile("" : "+v"(tid_));
    const int tid = tid_, wid = __builtin_amdgcn_readfirstlane(tid >> 6), lane = tid & 63, r32 = lane & 31, hi = lane >> 5;
    const int sr = tid >> 4, sc = (tid & 15) * 8, kws = FA_KSWZ(sr, sc * 2), vst0 = v_st(sr, sc), vst1 = v_st(32 + sr, sc);
    const int vb0 = (int)(unsigned)(size_t)(lds) + v_rd_base(lane);
    LAS float* al_l = (LAS float*)(lds + L_WS + wid * 256);
    const int W = (MODE == 2) ? X.W : (1 << 30);
    const int qlo = B.qpos, qm = qlo + r32 - 4 * hi;
    bf16x8 qr[8];
#pragma unroll
    for (int d0 = 0; d0 < 8; ++d0) qr[d0] = *(const bf16x8*)(B.Q + (size_t)r32 * B.qstride + d0 * 16 + hi * 8);
#pragma unroll
    for (int d = 0; d < 4; ++d) o[d] = f32x16{};
    m_reg = -1e30f; l_reg = 0.f;
    const int NT = B.j_hi - B.j_lo;
    Stage S;
    stage_load<MODE>(S, B, X, B.j_lo, sr, sc, tid);
    asm volatile("s_waitcnt vmcnt(0)" ::: "memory");
    stage_write<MODE>(S, lds, 0, kws, vst0, vst1, X.cref, tid);
    __syncthreads();
    f32x16 p0, p1; float mn, alpha; bf16x8 pa0, pa1, pa2, pa3;
#define FA_STEP(t, BUF) do { const int j_ = B.j_lo + (t), kb_ = j_ * KVBLK; \
        if ((t) + 1 < NT) stage_load<MODE>(S, B, X, j_ + 1, sr, sc, tid); \
        const bool act_ = (kb_ <= qlo + 31) && (kb_ + KVBLK - 1 >= qlo - W + 1); \
        if (act_) { \
            FA_SBAR(); qkt<BUF>(p0, p1, lds, r32, hi, qr); \
            if (MODE == 0) { const LAS f32x4* bp = (const LAS f32x4*)(lds + L_BIAS + BUF * 256) + hi; \
                _Pragma("unroll") for (int g_ = 0; g_ < 4; ++g_) { const f32x4 b0 = bp[2 * g_], b1 = bp[8 + 2 * g_]; \
                    _Pragma("unroll") for (int i_ = 0; i_ < 4; ++i_) { p0[4 * g_ + i_] += b0[i_]; p1[4 * g_ + i_] += b1[i_]; } } } \
            if (MODE == 1) { const bool sel_ = ((j_ < 32 ? (X.mlo >> j_) : (X.mhi >> (j_ - 32))) & 1u) != 0u; \
                if (!sel_) { const float NEG_ = -__builtin_inff(); _Pragma("unroll") for (int r = 0; r < 16; ++r) { p0[r] = NEG_; p1[r] = NEG_; } } } \
            if (kb_ + KVBLK - 1 > qlo || kb_ <= qlo + 31 - W) mask_tile(p0, p1, qm - kb_, (unsigned)W); \
            partialSM(p0, p1, m_reg, mn, alpha); \
            if (__any(alpha < 1.f)) { if (hi == 0) al_l[r32] = alpha; asm volatile("s_waitcnt lgkmcnt(0)" ::: "memory"); \
                _Pragma("unroll") for (int r = 0; r < 16; ++r) { const float a_ = al_l[crow(r, hi)]; _Pragma("unroll") for (int d_ = 0; d_ < 4; ++d_) o[d_][r] *= a_; } } \
            finishSM(p0, p1, alpha, l_reg, pa0, pa1, pa2, pa3); FA_SBAR(); \
            pv_tile<BUF>(o, vb0, pa0, pa1, pa2, pa3); } \
        if ((t) + 1 < NT) { asm volatile("s_waitcnt vmcnt(0)" ::: "memory"); stage_write<MODE>(S, lds, (BUF) ^ 1, kws, vst0, vst1, X.cref, tid); } \
        __syncthreads(); } while (0)
    for (int t = 0; t < NT; t += 2) { FA_STEP(t, 0); if (t + 1 < NT) FA_STEP(t + 1, 1); }
#undef FA_STEP
}

__device__ __forceinline__ float swap32(float v, int hi) {
    auto rr = __builtin_amdgcn_permlane32_swap(__float_as_uint(v), __float_as_uint(v), false, false);
    return __uint_as_float(hi ? rr[0] : rr[1]);
}
__device__ __forceinline__ void sb_weights(f32x16& p0, f32x16& p1, float& carry, int dq, bool needmask, int hi) {
    f32x16 l0, l1;
#pragma unroll
    for (int r = 0; r < 16; ++r) { const int c = (r & 3) + 8 * (r >> 2);
        { const float z = p0[r] * C2; const float sp = fmaxf(z, 0.f) + __builtin_amdgcn_logf(1.f + __builtin_amdgcn_exp2f(-fabsf(z))); const bool v = !needmask || (dq - c > 0); p0[r] = v ? z : -__builtin_inff(); l0[r] = v ? -sp : 0.f; }
        { const float z = p1[r] * C2; const float sp = fmaxf(z, 0.f) + __builtin_amdgcn_logf(1.f + __builtin_amdgcn_exp2f(-fabsf(z))); const bool v = !needmask || (dq - c - 32 > 0); p1[r] = v ? z : -__builtin_inff(); l1[r] = v ? -sp : 0.f; } }
    float T[8];
#pragma unroll
    for (int g = 0; g < 4; ++g) { l0[4 * g + 2] += l0[4 * g + 3]; l0[4 * g + 1] += l0[4 * g + 2]; l0[4 * g] += l0[4 * g + 1]; T[g] = l0[4 * g];
                                  l1[4 * g + 2] += l1[4 * g + 3]; l1[4 * g + 1] += l1[4 * g + 2]; l1[4 * g] += l1[4 * g + 1]; T[4 + g] = l1[4 * g]; }
    float ex[8], send[8]; float run = 0.f;
#pragma unroll
    for (int k = 7; k >= 0; --k) { ex[k] = run; run += T[k]; send[k] = hi ? run : ex[k]; }
    const float tot_all = run + swap32(run, hi);
#pragma unroll
    for (int k = 0; k < 8; ++k) { const float off = ex[k] + swap32(send[k], hi) + carry;
#pragma unroll
        for (int i = 0; i < 4; ++i) { if (k < 4) l0[4 * k + i] += off; else l1[4 * (k - 4) + i] += off; } }
#pragma unroll
    for (int r = 0; r < 16; ++r) { p0[r] = __builtin_amdgcn_exp2f(p0[r] + l0[r]); p1[r] = __builtin_amdgcn_exp2f(p1[r] + l1[r]); }
    carry += tot_all;
}
__device__ __forceinline__ void sb_block(LAS char* lds, const Blk& B, f32x16 (&o)[4]) {
    int tid_ = threadIdx.x; asm volatile("" : "+v"(tid_));
    const int tid = tid_, wid = __builtin_amdgcn_readfirstlane(tid >> 6), lane = tid & 63, r32 = lane & 31, hi = lane >> 5;
    const int sr = tid >> 4, sc = (tid & 15) * 8, kws = FA_KSWZ(sr, sc * 2), vst0 = v_st(sr, sc), vst1 = v_st(32 + sr, sc);
    const int vb0 = (int)(unsigned)(size_t)(lds) + v_rd_base(lane);
    volatile LAS unsigned* dflag = (volatile LAS unsigned*)(lds + L_MISC + 64);
    const int qlo = B.qpos, qm = qlo + r32 - 4 * hi;
    bf16x8 qr[8];
#pragma unroll
    for (int d0 = 0; d0 < 8; ++d0) qr[d0] = *(const bf16x8*)(B.Q + (size_t)r32 * B.qstride + d0 * 16 + hi * 8);
#pragma unroll
    for (int d = 0; d < 4; ++d) o[d] = f32x16{};
    float carry = 0.f; bool wdone = false;
    const int NT = B.j_hi - B.j_lo;
    Stage S; Extra X{};
    if (lane == 0) { dflag[wid] = 0u; dflag[8 + wid] = 0u; }
    stage_load<3>(S, B, X, B.j_hi - 1, sr, sc, tid);
    asm volatile("s_waitcnt vmcnt(0)" ::: "memory");
    stage_write<3>(S, lds, 0, kws, vst0, vst1, 0.f, tid);
    __syncthreads();
    f32x16 p0, p1; bf16x8 pa0, pa1, pa2, pa3;
#define FA_SBSTEP(t, BUF) do { const int j_ = B.j_hi - 1 - (t), kb_ = j_ * KVBLK; \
        if ((t) + 1 < NT) stage_load<3>(S, B, X, j_ - 1, sr, sc, tid); \
        const bool act_ = !wdone && (kb_ < qlo + 31); \
        if (act_) { \
            FA_SBAR(); qkt<BUF>(p0, p1, lds, r32, hi, qr); \
            sb_weights(p0, p1, carry, qm - kb_, kb_ + KVBLK - 1 >= qlo, hi); \
            FA_PK4(p0, 0, pa0); FA_PK4(p0, 8, pa1); FA_PK4(p1, 0, pa2); FA_PK4(p1, 8, pa3); FA_SBAR(); \
            pv_tile<BUF>(o, vb0, pa0, pa1, pa2, pa3); \
            wdone = __all(carry < -160.f); } \
        if (lane == 0) dflag[((t) & 1) * 8 + wid] = (wdone || kb_ == 0) ? 1u : 0u; \
        if ((t) + 1 < NT) { asm volatile("s_waitcnt vmcnt(0)" ::: "memory"); stage_write<3>(S, lds, (BUF) ^ 1, kws, vst0, vst1, 0.f, tid); } \
        __syncthreads(); \
        { unsigned all_ = 1u; _Pragma("unroll") for (int w_ = 0; w_ < 8; ++w_) all_ &= dflag[((t) & 1) * 8 + w_]; stop = all_ != 0u; } } while (0)
    bool stop = false;
    for (int t = 0; t < NT; t += 2) { FA_SBSTEP(t, 0); if (stop) break; if (t + 1 < NT) { FA_SBSTEP(t + 1, 1); if (stop) break; } }
#undef FA_SBSTEP
    __syncthreads();
}

__device__ __forceinline__ void row_scales(LAS char* lds, int wid, int r32, int hi, float rs, float (&sc)[16]) {
    LAS float* li_l = (LAS float*)(lds + L_WS + wid * 256) + 32;
    if (hi == 0) li_l[r32] = rs;
    asm volatile("s_waitcnt lgkmcnt(0)" ::: "memory");
#pragma unroll
    for (int r = 0; r < 16; ++r) sc[r] = li_l[crow(r, hi)];
    asm volatile("s_waitcnt lgkmcnt(0)" ::: "memory");
}
__device__ __forceinline__ void store_bf16(const f32x16 (&o)[4], const float (&sc)[16], bf16* dst, size_t ld, int r32, int hi) {
#pragma unroll
    for (int r = 0; r < 16; ++r) { const int orow = crow(r, hi);
#pragma unroll
        for (int d0 = 0; d0 < 4; ++d0) { const float v = o[d0][r] * sc[r]; const float vn = __shfl_xor(v, 1);
            if ((r32 & 1) == 0) *(unsigned*)(dst + (size_t)orow * ld + d0 * 32 + r32) = cvtpk(v, vn); } }
}
}

__device__ __forceinline__ void nsa_block(const Params& P, LAS char* lds, int b, int g, int qb) {
    unsigned char* ws = P.ws;
    const bf16* QKV = (const bf16*)(ws + WS_QKV);
    const float* GATE = (const float*)(ws + WS_GATE);
    int tid_ = threadIdx.x; asm volatile("" : "+v"(tid_));
    const int tid = tid_, wid = __builtin_amdgcn_readfirstlane(tid >> 6), lane = tid & 63, r32 = lane & 31, hi = lane >> 5;
    const int hh = wid & 3, tb = wid >> 2, h = 4 * g + hh, P0 = 64 * qb + 32 * tb, row0 = b * SEQ + P0;
    fa::Blk B; B.Q = head_ptr(QKV, HB_QA + h, b) + (size_t)P0 * HD; B.qstride = HD; B.kvstride = HD; B.qpos = P0;
    fa::f32x16 o[4]; float m_reg, l_reg; float sc[16];
    const float* oc = (const float*)(ws + WS_OCMP) + (size_t)row0 * 1024 + h * 128;
    float* os = (float*)(ws + WS_OS) + (size_t)row0 * 1024 + h * 128;
    {
        B.K = head_ptr(QKV, HB_KS + g, b); B.V = head_ptr(QKV, HB_VS + g, b); B.j_lo = 0; B.j_hi = qb + 1;
        const unsigned long long m = ((const unsigned long long*)(ws + WS_SEL))[(size_t)(b * 2 + g) * SEQ + P0 + r32];
        fa::Extra X{}; X.mlo = (unsigned)m; X.mhi = (unsigned)(m >> 32);
        fa::softmax_block<1>(lds, B, X, o, m_reg, l_reg);
        const float g1 = sigmoidf_(GATE[(size_t)(row0 + r32) * 32 + 3 * h + 1]);
        fa::row_scales(lds, wid, r32, hi, g1 / l_reg, sc);
#pragma unroll
        for (int r = 0; r < 16; ++r) { const int orow = fa::crow(r, hi);
#pragma unroll
            for (int d0 = 0; d0 < 4; ++d0) { const size_t off = (size_t)orow * 1024 + d0 * 32 + r32; os[off] = oc[off] + o[d0][r] * sc[r]; } }
    }
    {
        B.K = head_ptr(QKV, HB_KW + g, b); B.V = head_ptr(QKV, HB_VW + g, b); B.j_lo = qb >= 8 ? qb - 8 : 0; B.j_hi = qb + 1;
        fa::Extra X{}; X.W = 512;
        fa::softmax_block<2>(lds, B, X, o, m_reg, l_reg);
        const float g2 = sigmoidf_(GATE[(size_t)(row0 + r32) * 32 + 3 * h + 2]);
        fa::row_scales(lds, wid, r32, hi, g2 / l_reg, sc);
        asm volatile("s_waitcnt vmcnt(0)" ::: "memory"); __builtin_amdgcn_fence(__ATOMIC_ACQUIRE, "agent"); asm volatile("s_waitcnt vmcnt(0)" ::: "memory");
        unsigned char* mx = ws + WS_MIX + (size_t)row0 * MIXLD + MIXO8 + h * 128;
#pragma unroll
        for (int r = 0; r < 16; ++r) { const int orow = fa::crow(r, hi);
#pragma unroll
            for (int d0 = 0; d0 < 4; ++d0) { const float v = os[(size_t)orow * 1024 + d0 * 32 + r32] + o[d0][r] * sc[r]; const float vn = __shfl_xor(v, 1); const float v2 = __shfl_xor(v, 2), v3 = __shfl_xor(vn, 2);
                if ((r32 & 3) == 0) *(unsigned*)(mx + (size_t)orow * MIXLD + d0 * 32 + r32) = pk4_fp8(v, vn, v2, v3); } }
    }
}
__device__ __forceinline__ void fox_block(const Params& P, LAS char* lds, int b, int h, int x) {
    unsigned char* ws = P.ws;
    const bf16* QKV = (const bf16*)(ws + WS_QKV);
    int tid_ = threadIdx.x; asm volatile("" : "+v"(tid_));
    const int tid = tid_, wid = __builtin_amdgcn_readfirstlane(tid >> 6), lane = tid & 63, r32 = lane & 31, hi = lane >> 5;
    const int P0 = 256 * x + 32 * wid, row0 = b * SEQ + P0;
    fa::Blk B; B.Q = head_ptr(QKV, HB_QB + h, b) + (size_t)P0 * HD; B.qstride = HD; B.kvstride = HD; B.qpos = P0;
    B.K = head_ptr(QKV, HB_KB + h, b); B.V = head_ptr(QKV, HB_VB + h, b); B.j_lo = 0; B.j_hi = 4 * x + 4;
    fa::Extra X{}; X.cum = (const float*)(ws + WS_CUM) + (size_t)(b * 8 + h) * SEQ; X.cref = X.cum[256 * x];
    fa::f32x16 o[4]; float m_reg, l_reg; float sc[16];
    fa::softmax_block<0>(lds, B, X, o, m_reg, l_reg);
    fa::row_scales(lds, wid, r32, hi, 1.0f / l_reg, sc);
    fa::store_bf16(o, sc, (bf16*)(ws + WS_MIX) + (size_t)row0 * (MIXLD / 2) + h * 128, MIXLD / 2, r32, hi);
}
__device__ __forceinline__ void sbk_block(const Params& P, LAS char* lds, int b, int h, int x) {
    unsigned char* ws = P.ws;
    const bf16* QKV = (const bf16*)(ws + WS_QKV);
    int tid_ = threadIdx.x; asm volatile("" : "+v"(tid_));
    const int tid = tid_, wid = __builtin_amdgcn_readfirstlane(tid >> 6), lane = tid & 63, r32 = lane & 31, hi = lane >> 5;
    const int P0 = 256 * x + 32 * wid, row0 = b * SEQ + P0;
    fa::Blk B; B.Q = head_ptr(QKV, HB_QD + h, b) + (size_t)P0 * HD; B.qstride = HD; B.kvstride = HD; B.qpos = P0;
    B.K = head_ptr(QKV, HB_KD + h, b); B.V = head_ptr(QKV, HB_VD + h, b); B.j_lo = 0; B.j_hi = 4 * x + 4;
    fa::f32x16 o[4]; float sc[16];
    fa::sb_block(lds, B, o);
#pragma unroll
    for (int r = 0; r < 16; ++r) sc[r] = 1.f;
    fa::store_bf16(o, sc, (bf16*)(ws + WS_MIX) + (size_t)row0 * (MIXLD / 2) + 1024 + h * 128, MIXLD / 2, r32, hi);
}
constexpr int YQ_DIL = 3 * 16 * 16;
__device__ __forceinline__ void dil_block(const Params& P, LAS char* lds, int cfg, int b, int h, int blk) {
    unsigned char* ws = P.ws;
    const bf16* QKV = (const bf16*)(ws + WS_QKV);
    int tid_ = threadIdx.x; asm volatile("" : "+v"(tid_));
    const int tid = tid_, wid = __builtin_amdgcn_readfirstlane(tid >> 6), lane = tid & 63, r32 = lane & 31, hi = lane >> 5;
    const int d = cfg == 0 ? 1 : (cfg == 1 ? 4 : 16), nb = 16 / d, res = blk / nb, xb = blk % nb, U0 = 256 * xb + 32 * wid;
    fa::Blk B; B.Q = head_ptr(QKV, HB_QC + h, b) + (size_t)(res + d * U0) * HD; B.qstride = d * HD; B.kvstride = d * HD; B.qpos = U0;
    B.K = head_ptr(QKV, HB_KCC + h, b) + (size_t)res * HD; B.V = head_ptr(QKV, HB_VCC + h, b) + (size_t)res * HD; B.j_lo = xb ? 4 * xb - 2 : 0; B.j_hi = 4 * xb + 4;
    fa::Extra X{}; X.W = 129;
    fa::f32x16 o[4]; float m_reg, l_reg; float sc[16];
    fa::softmax_block<2>(lds, B, X, o, m_reg, l_reg);
    fa::row_scales(lds, wid, r32, hi, 1.0f / l_reg, sc);
    float* dout = (float*)(ws + WS_DO) + (size_t)cfg * MROWS * 1024 + (size_t)(b * SEQ + res + d * U0) * 1024 + h * 128;
#pragma unroll
    for (int r = 0; r < 16; ++r) { const int orow = fa::crow(r, hi);
#pragma unroll
        for (int d0 = 0; d0 < 4; ++d0) dout[(size_t)orow * d * 1024 + d0 * 32 + r32] = o[d0][r] * sc[r]; }
    if (hi == 0) ((float*)(ws + WS_LSE))[(size_t)cfg * MROWS * 8 + (size_t)(b * SEQ + res + d * (U0 + r32)) * 8 + h] = m_reg * fa::SCALE + logf(l_reg);
}
__device__ __forceinline__ void phaseZ_dil_combine(const Params& P, int gw, int NGW, int lane) {
    unsigned char* ws = P.ws;
    const float* DO = (const float*)(ws + WS_DO); const float* LSE = (const float*)(ws + WS_LSE);
    const int h = lane >> 3, c0 = (lane & 7) * 16;
    for (int row = gw; row < MROWS; row += NGW) {
        const float l0 = LSE[(size_t)row * 8 + h], l1 = LSE[(size_t)MROWS * 8 + (size_t)row * 8 + h], l2 = LSE[(size_t)2 * MROWS * 8 + (size_t)row * 8 + h];
        const float mx = fmaxf(l0, fmaxf(l1, l2)); float w0 = __expf(l0 - mx), w1 = __expf(l1 - mx), w2 = __expf(l2 - mx); const float inv = 1.0f / (w0 + w1 + w2); w0 *= inv; w1 *= inv; w2 *= inv;
        const float* p0 = DO + (size_t)row * 1024 + h * 128 + c0; const float* p1 = p0 + (size_t)MROWS * 1024; const float* p2 = p1 + (size_t)MROWS * 1024;
        unsigned char* dst = ws + WS_MIX + (size_t)row * MIXLD + MIXO8 + 1024 + h * 128 + c0;
#pragma unroll
        for (int q = 0; q < 2; ++q) { const f32x4 a0 = *(const f32x4*)(p0 + 8 * q), a1 = *(const f32x4*)(p0 + 8 * q + 4), b0 = *(const f32x4*)(p1 + 8 * q), b1 = *(const f32x4*)(p1 + 8 * q + 4), c0v = *(const f32x4*)(p2 + 8 * q), c1v = *(const f32x4*)(p2 + 8 * q + 4);
            const f32x4 o0 = a0 * w0 + b0 * w1 + c0v * w2, o1 = a1 * w0 + b1 * w1 + c1v * w2;
            v2u w; w.x = pk4_fp8(o0[0], o0[1], o0[2], o0[3]); w.y = pk4_fp8(o1[0], o1[1], o1[2], o1[3]);
            *(v2u*)(dst + 8 * q) = w; }
    }
}


constexpr int YQ_CMP = 256;
__device__ __forceinline__ void cmp_block(const Params& P, LAS char* lds, int b, int g, int qb) {
    using namespace fa;
    unsigned char* ws = P.ws;
    const bf16* QKV = (const bf16*)(ws + WS_QKV);
    const float* GATE = (const float*)(ws + WS_GATE);
    int tid_ = threadIdx.x; asm volatile("" : "+v"(tid_));
    const int tid = tid_, wid = __builtin_amdgcn_readfirstlane(tid >> 6), lane = tid & 63, r32 = lane & 31, hi = lane >> 5;
    const int tok = r32 >> 2, hh = r32 & 3, h = 4 * g + hh, bg = b * 2 + g;
    const int t = 64 * qb + 8 * wid + tok, row = b * SEQ + t;
    const bf16* qp = head_ptr(QKV, HB_QA + h, b) + (size_t)t * HD;
    bf16x8 qr[8];
#pragma unroll
    for (int d0 = 0; d0 < 8; ++d0) qr[d0] = *(const bf16x8*)(qp + d0 * 16 + hi * 8);
    Blk B{}; B.K = (const bf16*)(ws + WS_KC) + (size_t)bg * 256 * HD; B.V = (const bf16*)(ws + WS_VC) + (size_t)bg * 256 * HD; B.kvstride = HD;
    const int NT = (4 * qb + 66) >> 6;
    const int pos = (t >= 31 ? ((t - 15) >> 4) : 0) - 1, qm = pos - 4 * hi;
    const int tl = 64 * qb + 8 * wid + 7, posmax = (tl >= 31 ? ((tl - 15) >> 4) : 0) - 1;
    const int sr = tid >> 4, sc = (tid & 15) * 8, kws = FA_KSWZ(sr, sc * 2), vst0 = v_st(sr, sc), vst1 = v_st(32 + sr, sc);
    const int vb0 = (int)(unsigned)(size_t)(lds) + v_rd_base(lane);
    float m_reg = -1e30f, l_reg = 0.f, mn, alpha;
    Stage S; Extra X{};
    f32x16 p0, p1;
    stage_load<3>(S, B, X, 0, sr, sc, tid); asm volatile("s_waitcnt vmcnt(0)" ::: "memory"); stage_write<3>(S, lds, 0, kws, vst0, vst1, 0.f, tid); __syncthreads();
#define CMP_P1(T) if ((T) < NT) { \
        if ((T) + 1 < NT) stage_load<3>(S, B, X, (T) + 1, sr, sc, tid); \
        if (64 * (T) <= posmax) { FA_SBAR(); qkt<(T) & 1>(p0, p1, lds, r32, hi, qr); mask_tile(p0, p1, qm - 64 * (T), 1u << 30); partialSM(p0, p1, m_reg, mn, alpha); \
            float ps_ = 0.f; _Pragma("unroll") for (int r = 0; r < 16; ++r) ps_ += p0[r] + p1[r]; \
            { auto rr = __builtin_amdgcn_permlane32_swap(__float_as_uint(ps_), __float_as_uint(ps_), false, false); ps_ = __uint_as_float(rr[0]) + __uint_as_float(rr[1]); } \
            l_reg = l_reg * alpha + ps_; } \
        if ((T) + 1 < NT) { asm volatile("s_waitcnt vmcnt(0)" ::: "memory"); stage_write<3>(S, lds, ((T) & 1) ^ 1, kws, vst0, vst1, 0.f, tid); } \
        __syncthreads(); }
    CMP_P1(0) CMP_P1(1) CMP_P1(2) CMP_P1(3)
#undef CMP_P1
    const float inv_l = l_reg > 0.f ? 1.0f / l_reg : 0.f, mC = -m_reg * C2;
    f32x16 o[4];
#pragma unroll
    for (int d = 0; d < 4; ++d) o[d] = f32x16{};
    float IMP[4][8];
#pragma unroll
    for (int a = 0; a < 4; ++a)
#pragma unroll
        for (int k = 0; k < 8; ++k) IMP[a][k] = 0.f;
    bf16x8 pa0, pa1, pa2, pa3;
    stage_load<3>(S, B, X, 0, sr, sc, tid); asm volatile("s_waitcnt vmcnt(0)" ::: "memory"); stage_write<3>(S, lds, 0, kws, vst0, vst1, 0.f, tid); __syncthreads();
#define CMP_P2(T) if ((T) < NT) { \
        if ((T) + 1 < NT) stage_load<3>(S, B, X, (T) + 1, sr, sc, tid); \
        if (64 * (T) <= posmax) { FA_SBAR(); qkt<(T) & 1>(p0, p1, lds, r32, hi, qr); mask_tile(p0, p1, qm - 64 * (T), 1u << 30); \
            _Pragma("unroll") for (int r = 0; r < 16; ++r) { p0[r] = __builtin_amdgcn_exp2f(fmaf(p0[r], C2, mC)) * inv_l; p1[r] = __builtin_amdgcn_exp2f(fmaf(p1[r], C2, mC)) * inv_l; } \
            float A_[8], R_[8]; \
            _Pragma("unroll") for (int k = 0; k < 4; ++k) { A_[k] = p0[4 * k] + 2.f * (p0[4 * k + 1] + p0[4 * k + 2] + p0[4 * k + 3]); A_[4 + k] = p1[4 * k] + 2.f * (p1[4 * k + 1] + p1[4 * k + 2] + p1[4 * k + 3]); \
                R_[k] = swap32(p0[4 * k], hi); R_[4 + k] = swap32(p1[4 * k], hi); } \
            _Pragma("unroll") for (int k = 0; k < 8; ++k) IMP[T][k] += A_[k] + (hi ? (k < 7 ? R_[k < 7 ? k + 1 : 7] : 0.f) : R_[k]); \
            if ((T) > 0) IMP[(T) > 0 ? (T) - 1 : 0][7] += hi ? R_[0] : 0.f; \
            FA_PK4(p0, 0, pa0); FA_PK4(p0, 8, pa1); FA_PK4(p1, 0, pa2); FA_PK4(p1, 8, pa3); FA_SBAR(); \
            pv_tile<(T) & 1>(o, vb0, pa0, pa1, pa2, pa3); } \
        if ((T) + 1 < NT) { asm volatile("s_waitcnt vmcnt(0)" ::: "memory"); stage_write<3>(S, lds, ((T) & 1) ^ 1, kws, vst0, vst1, 0.f, tid); } \
        __syncthreads(); }
    CMP_P2(0) CMP_P2(1) CMP_P2(2) CMP_P2(3)
#undef CMP_P2
    { float scl[16]; const float g0 = sigmoidf_(GATE[(size_t)row * 32 + 3 * h]);
      row_scales(lds, wid, r32, hi, g0, scl);
      float* oc = (float*)(ws + WS_OCMP) + (size_t)(b * SEQ + 64 * qb + 8 * wid) * 1024 + 4 * g * 128;
#pragma unroll
      for (int r = 0; r < 16; ++r) { const int orow = crow(r, hi);
#pragma unroll
          for (int d0 = 0; d0 < 4; ++d0) oc[(size_t)(orow >> 2) * 1024 + (orow & 3) * 128 + d0 * 32 + r32] = o[d0][r] * scl[r]; } }
    unsigned long long* SELp = (unsigned long long*)(ws + WS_SEL) + (size_t)bg * SEQ + 64 * qb + 8 * wid;
    if (qb < 16) { if (lane < 8) SELp[lane] = 0xFFFFull; }
    else {
        LAS float* scs = (LAS float*)(lds + 73728) + wid * 512;
#pragma unroll
        for (int a = 0; a < 4; ++a)
#pragma unroll
            for (int k = 0; k < 8; ++k) { float v = IMP[a][k]; v += __shfl_xor(v, 1); v += __shfl_xor(v, 2); if (hh == 0) scs[tok * 64 + 16 * a + 2 * k + hi] = v; }
        asm volatile("s_waitcnt lgkmcnt(0)" ::: "memory");
        const int j = lane; const bool causal = j <= qb, forced = (j == 0) || (j == qb) || (j == qb - 1);
        for (int tk = 0; tk < 8; ++tk) {
            const float imp = scs[tk * 64 + lane];
            const float score = causal ? (forced ? 1e9f : imp) : -1.f;
            int rank = 0;
#pragma unroll 16
            for (int jj = 0; jj < 64; ++jj) { const float sj = __shfl(score, jj); rank += (sj > score || (sj == score && jj < j)) ? 1 : 0; }
            const unsigned long long mask = __ballot(rank < 16);
            if (lane == 0) SELp[tk] = mask;
        }
        asm volatile("s_waitcnt lgkmcnt(0)" ::: "memory");
    }
}
namespace pg8 {
struct CmpOrder {
    int c;
    __device__ __forceinline__ bool next(int i, Unit& u) const { if (i != 0 || c >= 8) return false; u.pm = c; u.pn = c >> 2; u.idx = 0; return true; }
    __device__ __forceinline__ void a_ready(const Unit&) const {}
    __device__ __forceinline__ void done(const Unit&) const {}
};
struct EpiCmp {
    static constexpr bool PERM = true, AFTER_DRAIN = true;
    bf16_t* hid; const bf16_t* w2t; const PG8_LAS float* bias; bf16_t* kcb; bf16_t* vcb;
    __device__ __forceinline__ void fused(f32x4 (&acc)[2][2][4][2], const Unit& u, int wr, int wc, int fr, int fq, PG8_LAS unsigned char* lds, int wid, int lane) const {
        const int kv = u.pn, row0 = u.pm * BM + wr * 64 + fr;
#pragma unroll
        for (int bj = 0; bj < 2; ++bj) { const int col = bj * HALF + wc * 32 + 8 * fq;
            const f32x4 b0 = *(const PG8_LAS f32x4*)(bias + col), b1 = *(const PG8_LAS f32x4*)(bias + col + 4);
#pragma unroll
            for (int ai = 0; ai < 2; ++ai)
#pragma unroll
                for (int m = 0; m < 4; ++m) { f32x4 v0 = acc[ai][bj][m][0] + b0, v1 = acc[ai][bj][m][1] + b1;
#pragma unroll
                    for (int i = 0; i < 4; ++i) { { const float x = v0[i], uu = 0.7978845608028654f * (x + 0.044715f * x * x * x), e = __expf(2.f * uu); v0[i] = 0.5f * x * (1.0f + (1.0f - 2.0f / (e + 1.0f))); }
                                                  { const float x = v1[i], uu = 0.7978845608028654f * (x + 0.044715f * x * x * x), e = __expf(2.f * uu); v1[i] = 0.5f * x * (1.0f + (1.0f - 2.0f / (e + 1.0f))); } }
                    u32x4 w; w.x = cvt_pk_bf16(v0[0], v0[1]); w.y = cvt_pk_bf16(v0[2], v0[3]); w.z = cvt_pk_bf16(v1[0], v1[1]); w.w = cvt_pk_bf16(v1[2], v1[3]);
                    *(u32x4*)(hid + (size_t)(row0 + ai * HALF + m * 16) * 256 + col) = w; } }
        asm volatile("s_waitcnt vmcnt(0)" ::: "memory"); __syncthreads();
        __builtin_amdgcn_fence(__ATOMIC_ACQUIRE, "agent"); asm volatile("s_waitcnt vmcnt(0)" ::: "memory");
        typedef float f32x16 __attribute__((ext_vector_type(16)));
        const int r32 = lane & 31, hi = lane >> 5;
        const bf16_t* hp = hid + (size_t)(u.pm * BM + wid * 32 + r32) * 256 + hi * 8;
        const bf16_t* wp = w2t + (size_t)kv * 128 * 256 + (size_t)r32 * 256 + hi * 8;
        f32x16 c2[4];
#pragma unroll
        for (int nt = 0; nt < 4; ++nt) c2[nt] = f32x16{};
#pragma unroll 4
        for (int ks = 0; ks < 16; ++ks) { const bf16x8 a = *(const bf16x8*)(hp + ks * 16);
#pragma unroll
            for (int nt = 0; nt < 4; ++nt) { const bf16x8 bb = *(const bf16x8*)(wp + (size_t)nt * 32 * 256 + ks * 16); c2[nt] = __builtin_amdgcn_mfma_f32_32x32x16_bf16(a, bb, c2[nt], 0, 0, 0); } }
        const int g = (u.pm >> 1) & 1, b = u.pm & 1, bgd = b * 2 + g;
        bf16_t* dst = (kv ? vcb : kcb) + (size_t)bgd * 256 * 128;
#pragma unroll
        for (int nt = 0; nt < 4; ++nt)
#pragma unroll
            for (int r = 0; r < 16; ++r) { const int crow_ = (r & 3) + 8 * (r >> 2) + 4 * hi; const float v = c2[nt][r];
                dst[(size_t)(wid * 32 + crow_) * 128 + nt * 32 + r32] = (bf16_t)((__builtin_bit_cast(unsigned, v) + 0x7fffu + ((__builtin_bit_cast(unsigned, v) >> 16) & 1u)) >> 16); }
    }
};
}


constexpr int XQ_SB = 256, XQ_TOTAL = XQ_SB + YQ_DIL, ZQ_TOTAL = 512;
__constant__ unsigned short ZTAB[ZQ_TOTAL] = {252, 253, 254, 255, 248, 249, 250, 251, 244, 245, 246, 247, 240, 241, 242, 243, 236, 237, 238, 239, 232, 233, 234, 235, 228, 229, 230, 231, 224, 225, 226, 227, 220, 221, 222, 223, 216, 217, 218, 219, 212, 213, 214, 215, 208, 209, 210, 211, 33008, 33009, 33010, 33011, 33012, 33013, 33014, 33015, 33016, 33017, 33018, 33019, 33020, 33021, 33022, 33023, 204, 205, 206, 207, 200, 201, 202, 203, 196, 197, 198, 199, 192, 193, 194, 195, 32992, 32993, 32994, 32995, 32996, 32997, 32998, 32999, 33000, 33001, 33002, 33003, 33004, 33005, 33006, 33007, 188, 189, 190, 191, 184, 185, 186, 187, 180, 181, 182, 183, 176, 177, 178, 179, 32976, 32977, 32978, 32979, 32980, 32981, 32982, 32983, 32984, 32985, 32986, 32987, 32988, 32989, 32990, 32991, 172, 173, 174, 175, 168, 169, 170, 171, 164, 165, 166, 167, 160, 161, 162, 163, 32960, 32961, 32962, 32963, 32964, 32965, 32966, 32967, 32968, 32969, 32970, 32971, 32972, 32973, 32974, 32975, 156, 157, 158, 159, 152, 153, 154, 155, 148, 149, 150, 151, 144, 145, 146, 147, 32944, 32945, 32946, 32947, 32948, 32949, 32950, 32951, 32952, 32953, 32954, 32955, 32956, 32957, 32958, 32959, 140, 141, 142, 143, 136, 137, 138, 139, 132, 133, 134, 135, 128, 129, 130, 131, 32928, 32929, 32930, 32931, 32932, 32933, 32934, 32935, 32936, 32937, 32938, 32939, 32940, 32941, 32942, 32943, 124, 125, 126, 127, 120, 121, 122, 123, 116, 117, 118, 119, 112, 113, 114, 115, 32912, 32913, 32914, 32915, 32916, 32917, 32918, 32919, 32920, 32921, 32922, 32923, 32924, 32925, 32926, 32927, 108, 109, 110, 111, 104, 105, 106, 107, 100, 101, 102, 103, 96, 97, 98, 99, 32896, 32897, 32898, 32899, 32900, 32901, 32902, 32903, 32904, 32905, 32906, 32907, 32908, 32909, 32910, 32911, 92, 93, 94, 95, 88, 89, 90, 91, 84, 85, 86, 87, 80, 81, 82, 83, 32880, 32881, 32882, 32883, 32884, 32885, 32886, 32887, 32888, 32889, 32890, 32891, 32892, 32893, 32894, 32895, 76, 77, 78, 79, 72, 73, 74, 75, 68, 69, 70, 71, 64, 65, 66, 67, 32864, 32865, 32866, 32867, 32868, 32869, 32870, 32871, 32872, 32873, 32874, 32875, 32876, 32877, 32878, 32879, 60, 61, 62, 63, 56, 57, 58, 59, 52, 53, 54, 55, 48, 49, 50, 51, 32848, 32849, 32850, 32851, 32852, 32853, 32854, 32855, 32856, 32857, 32858, 32859, 32860, 32861, 32862, 32863, 44, 45, 46, 47, 40, 41, 42, 43, 36, 37, 38, 39, 32, 33, 34, 35, 32832, 32833, 32834, 32835, 32836, 32837, 32838, 32839, 32840, 32841, 32842, 32843, 32844, 32845, 32846, 32847, 28, 29, 30, 31, 24, 25, 26, 27, 20, 21, 22, 23, 16, 17, 18, 19, 32816, 32817, 32818, 32819, 32820, 32821, 32822, 32823, 32824, 32825, 32826, 32827, 32828, 32829, 32830, 32831, 12, 13, 14, 15, 8, 9, 10, 11, 4, 5, 6, 7, 0, 1, 2, 3, 32800, 32801, 32802, 32803, 32804, 32805, 32806, 32807, 32808, 32809, 32810, 32811, 32812, 32813, 32814, 32815, 32784, 32785, 32786, 32787, 32788, 32789, 32790, 32791, 32792, 32793, 32794, 32795, 32796, 32797, 32798, 32799, 32768, 32769, 32770, 32771, 32772, 32773, 32774, 32775, 32776, 32777, 32778, 32779, 32780, 32781, 32782, 32783};
__device__ __forceinline__ int queue_pop(LAS char* lds, unsigned* qctr) {
    volatile LAS int* qslot = (volatile LAS int*)(lds + fa::L_MISC);
    if (threadIdx.x == 0) qslot[0] = (int)__hip_atomic_fetch_add(qctr, 1u, __ATOMIC_RELAXED, __HIP_MEMORY_SCOPE_AGENT);
    __syncthreads();
    const int item = __builtin_amdgcn_readfirstlane(qslot[0]);
    __syncthreads();
    return item;
}
__device__ __forceinline__ void phaseX_queue(const Params& P, LAS unsigned char* lds_, unsigned* qctr) {
    LAS char* lds = (LAS char*)lds_;
    for (;;) {
        const int item = queue_pop(lds, qctr);
        if (item >= XQ_TOTAL) break;
        if (item < XQ_SB) { const int bh = item & 15, x = 15 - (item >> 4); sbk_block(P, lds, bh >> 3, bh & 7, x); }
        else { const int it = item - XQ_SB, cfg = it / 256, r = it % 256, bh = r & 15, blk = r >> 4; dil_block(P, lds, cfg, bh >> 3, bh & 7, blk); }
    }
}
__device__ __forceinline__ void phaseZ_queue(const Params& P, LAS unsigned char* lds_, unsigned* qctr) {
    LAS char* lds = (LAS char*)lds_;
    for (;;) {
        const int item = queue_pop(lds, qctr);
        if (item >= ZQ_TOTAL) break;
        const unsigned code = ZTAB[item];
        if ((code >> 15) == 0u) { const int bg = code & 3, qb = (code >> 2) & 63;
            cmp_block(P, lds, bg >> 1, bg & 1, qb);
            asm volatile("s_waitcnt vmcnt(0)" ::: "memory"); __syncthreads(); __builtin_amdgcn_fence(__ATOMIC_ACQUIRE, "agent"); asm volatile("s_waitcnt vmcnt(0)" ::: "memory");
            nsa_block(P, lds, bg >> 1, bg & 1, qb); }
        else { const int bh = code & 15, x = (code >> 4) & 15; fox_block(P, lds, bh >> 3, bh & 7, x); }
    }
}

__device__ __forceinline__ void cumsum_wave(const Params& P, int l, int idx, int lane) {
    unsigned char* ws = P.ws; const float* GATE = (const float*)(ws + WS_GATE);
    const int b = idx >> 3, h = idx & 7; const float fb = ((const float*)P.in[I_FOXB])[l * 8 + h];
    float* cum = (float*)(ws + WS_CUM) + (size_t)idx * SEQ;
    double s = 0.0;
    for (int i = 0; i < 64; ++i) { const int t = lane * 64 + i; s += (double)log_sigmoid_f(GATE[(size_t)(b * SEQ + t) * 32 + 24 + h] + fb); }
    double incl = s;
#pragma unroll
    for (int o = 1; o < 64; o <<= 1) { const double y = __shfl_up(incl, o); if (lane >= o) incl += y; }
    double run = incl - s;
    for (int i = 0; i < 64; ++i) { const int t = lane * 64 + i; run += (double)log_sigmoid_f(GATE[(size_t)(b * SEQ + t) * 32 + 24 + h] + fb); cum[t] = (float)run; }
}

#ifndef REP_PHASE
#define REP_PHASE (-1)
#endif
#define NREP(k) (((k) == REP_PHASE) ? 2 : 1)
template <int l>
__device__ __forceinline__ void layer_phases(const Params& P, LAS unsigned char* lds, const XcdBarrier& bar, const int lo, const int hi) {
    int tid_ = threadIdx.x; asm volatile("" : "+v"(tid_));
    const int tid = tid_, lane = tid & 63, wave = __builtin_amdgcn_readfirstlane(tid >> 6);
    const int G = gridDim.x, blk = blockIdx.x;
    const int gw = blk * NWAVES + wave, NGW = G * NWAVES;
    unsigned char* ws = P.ws;
#define IN(k) (lo <= (k) && (k) < hi)
#define SEAM(k) do { if ((k) + 1 < hi) xcd_barrier(bar); } while (0)
#define PHASE(k) if (IN(k)) for (int rep = 0; rep < NREP(k); ++rep)
#define REPBAR() do { if (rep) xcd_barrier(bar); } while (0)
    const int pb = 1 + PH_PER_LAYER * l;
    unsigned char* wl = ws + WS_W + (size_t)l * LAYER_W;
    bf16* H = (bf16*)(ws + WS_H);
    const void* hin = l == 0 ? (const void*)P.in[I_X] : (const void*)H;
    bf16* XN = (bf16*)(ws + WS_XN);
    float* SSA = (float*)(ws + WS_SSA); float* SSB = (float*)(ws + WS_SSB);
    unsigned* qc = (unsigned*)(ws + WS_CTL) + 64 * (8 + 8 * l);
    PHASE(pb + 0) { REPBAR();
        { pg8::Gemm g{(const bf16*)(ws + WS_XN8), (const bf16*)(wl + W_IN + W_IN8), MROWS, N8P * 256, DM}; pg8::StaticOrder S; S.init(MROWS, N8P * 256, G, blk);
          if (l > 0) rstd_prepass(lds, S, SSA);
          pg8::EpiProj<(l > 0), true> E{(bf16*)(ws + WS_QKV), (float*)(ws + WS_GATE), (const float*)(ws + WS_ROPE), (const LAS float*)(lds + LRSTD_OFF)};
          pg8::gemm_phase<pg8::EpiProj<(l > 0), true>, pg8::StaticOrder, true, true, true, 0x79797979>(lds + RING_OFF, g, S, E); }
        { pg8::Gemm g{l == 0 ? XN : (const bf16*)H, (const bf16*)(wl + W_IN), MROWS, N16P * 256, DM}; pg8::StaticOrder S; S.init(MROWS, N16P * 256, G, blk);
          if (l > 0) rstd_prepass(lds, S, SSA);
          pg8::EpiProj<(l > 0), false> E{(bf16*)(ws + WS_QKV), (float*)(ws + WS_GATE), (const float*)(ws + WS_ROPE), (const LAS float*)(lds + LRSTD_OFF)};
          pg8::gemm_phase<pg8::EpiProj<(l > 0), false>, pg8::StaticOrder, true, true>(lds + RING_OFF, g, S, E); } }
    if (IN(pb + 0)) SEAM(pb + 0);
    PHASE(pb + 1) { REPBAR();
        if (blk < 8) { LAS float* lbias = (LAS float*)(lds + LDSCTL_OFF + 1024); const int kv = blk >> 2;
            if (tid < 256) { const float* p = (const float*)(ws + WS_CBP) + (size_t)((l * 2 + kv) * 64) * 256 + tid; float s = 0.f;
#pragma unroll 16
                for (int kc = 0; kc < 64; ++kc) s += p[(size_t)kc * 256];
                lbias[tid] = s; }
            __syncthreads();
            pg8::Gemm g{(const bf16*)(ws + WS_QKV) + (size_t)16 * SEQ * HD, (const bf16*)(wl + W_C1K), 2048, 512, 4096, 2048, 4096}; pg8::CmpOrder S{blk};
            pg8::EpiCmp E{(bf16*)(ws + WS_HID), (const bf16*)(wl + W_C2K), (const LAS float*)lbias, (bf16*)(ws + WS_KC), (bf16*)(ws + WS_VC)};
            pg8::gemm_phase<pg8::EpiCmp, pg8::CmpOrder, false, true>(lds + RING_OFF, g, S, E);
            }
        if (gw >= 64 && gw < 80) cumsum_wave(P, l, gw - 64, lane);
        __syncthreads();
        phaseX_queue(P, lds, qc + 64 * rep); }
    if (IN(pb + 1)) SEAM(pb + 1);
    PHASE(pb + 2) { REPBAR(); phaseZ_dil_combine(P, gw, NGW, lane); phaseZ_queue(P, lds, qc + 128 + 64 * rep); }
    if (IN(pb + 2)) SEAM(pb + 2);
    PHASE(pb + 3) { REPBAR();
        pg8::Gemm2 g{ws + WS_MIX, wl + W_O, MIXLD, MIXO8, 2048, 2048}; pg8::StaticOrder S; S.init(MROWS, DM, G, blk);
        pg8::EpiResid<(l == 0), false> E{hin, H, DM, nullptr, SSA};
        pg8::gemm_phase_mixed<pg8::EpiResid<(l == 0), false>, pg8::StaticOrder, 0x79797979>(lds + RING_OFF, g, S, E); }
    if (IN(pb + 3)) SEAM(pb + 3);
    PHASE(pb + 4) { REPBAR();
        pg8::Gemm g{H, (const bf16*)(wl + W_UP), MROWS, DFF, DM}; pg8::StaticOrder S; S.init(MROWS, DFF, G, blk);
        rstd_prepass(lds, S, SSA);
        pg8::EpiAct<2> E{(bf16*)(ws + WS_FF), DFF, (const LAS float*)(lds + LRSTD_OFF)};
        pg8::gemm_phase<pg8::EpiAct<2>, pg8::StaticOrder, true, true>(lds + RING_OFF, g, S, E); }
    if (IN(pb + 4)) SEAM(pb + 4);
    PHASE(pb + 5) { REPBAR();
        pg8::Gemm g{(const bf16*)(ws + WS_FF), (const bf16*)(wl + W_DN), MROWS, DM, DFF}; pg8::StaticOrder S; S.init(MROWS, DM, G, blk);
        pg8::EpiResid<false, true> E{H, H, DM, (unsigned char*)XN, SSB};
        pg8::gemm_phase<pg8::EpiResid<false, true>, pg8::StaticOrder, true, true>(lds + RING_OFF, g, S, E); }
    if (IN(pb + 5)) SEAM(pb + 5);
    PHASE(pb + 6) { REPBAR();
        { pg8::Gemm g{(const bf16*)(ws + WS_PB) + (size_t)l * MROWS * PLE, (const bf16*)(wl + W_PP), MROWS, DM, PLE}; pg8::StaticOrder S; S.init(MROWS, DM, G, blk);
          pg8::EpiAct<0> E{(bf16*)(ws + WS_PP), DM, nullptr};
          pg8::gemm_phase<pg8::EpiAct<0>, pg8::StaticOrder, true, true>(lds + RING_OFF, g, S, E); }
        VM_WAIT(); __builtin_amdgcn_fence(__ATOMIC_ACQUIRE, "agent"); VM_WAIT(); __syncthreads();
        { pg8::Gemm g{XN, (const bf16*)(wl + W_G), MROWS, DM, DM}; pg8::StaticOrder S; S.init(MROWS, DM, G, blk);
          rstd_prepass(lds, S, SSB);
          pg8::EpiPle<(l + 1 < DEPTH)> E{H, (const bf16*)(ws + WS_PP), DM, (const LAS float*)(lds + LRSTD_OFF), SSA, ws + WS_XN8};
          pg8::gemm_phase<pg8::EpiPle<(l + 1 < DEPTH)>, pg8::StaticOrder, true, true, true, 0x79797979>(lds + RING_OFF, g, S, E); } }
    if (IN(pb + 6)) SEAM(pb + 6);
#undef IN
#undef SEAM
#undef PHASE
#undef REPBAR
}


__global__ void __launch_bounds__(NTHREADS, 2) hybrid_fwd(Params P) {
    extern __shared__ __attribute__((aligned(16))) unsigned char lds_raw[];
    LAS unsigned char* lds = (LAS unsigned char*)lds_raw;
    volatile LAS unsigned* MISC = (volatile LAS unsigned*)(lds + MISC_OFF);
    const int tid = threadIdx.x, lane = tid & 63, wave = __builtin_amdgcn_readfirstlane(tid >> 6);
    const int G = gridDim.x, blk = blockIdx.x;
    const int gw = blk * NWAVES + wave, NGW = G * NWAVES;
    unsigned char* ws = P.ws;
    for (int u = tid; u < (LDS_BYTES - LDSCTL_OFF) / 4; u += NTHREADS) ((LAS unsigned*)(lds + LDSCTL_OFF))[u] = 0u;
    __syncthreads();
    XcdBarrier bar = xcd_barrier_post((unsigned*)(ws + WS_CTL) + CW_BAR, MISC + 8);
    const int lo = P.ph_lo, hi = P.ph_hi;
#define IN(k) (lo <= (k) && (k) < hi)
#define SEAM(k) do { if ((k) + 1 < hi) xcd_barrier(bar); } while (0)

    #ifndef NO_P0
    if (IN(0)) { for (int rep = 0; rep < NREP(0); ++rep) { if (rep) xcd_barrier(bar); prologue_phase(P, lds, gw, NGW, wave, lane, rep); } SEAM(0); }
#endif

    layer_phases<0>(P, lds, bar, lo, hi);
    layer_phases<1>(P, lds, bar, lo, hi);
    if (IN(NPH - 1)) {
        norm_phase<true, true>((const float*)(ws + WS_H), (const float*)P.in[I_NFIN], P.out, gw, NGW, lane);
    }
#undef IN
#undef SEAM
}

#ifndef N_LAUNCH_MODE
#define N_LAUNCH_MODE 1
#endif
extern "C" void kernel_launch(void* const* d_in, const int* in_sizes, int n_in, void* d_out, int out_size, void* d_ws, size_t ws_size, hipStream_t stream) {
    static int grid = 0;
    if (grid == 0) {
        if (n_in != 20 || in_sizes[0] != MROWS * DM || out_size != MROWS * DM || ws_size < WS_END) { fprintf(stderr, "kernel_launch: unexpected shapes (n_in %d, in0 %d, out %d, ws %zu)\n", n_in, n_in > 0 ? in_sizes[0] : -1, out_size, ws_size); grid = -1; return; }
        int dev = 0, cus = 0, per_cu = 0;
        if (hipGetDevice(&dev) != hipSuccess || hipDeviceGetAttribute(&cus, hipDeviceAttributeMultiprocessorCount, dev) != hipSuccess) { grid = -1; return; }
        if (hipFuncSetAttribute((const void*)hybrid_fwd, hipFuncAttributeMaxDynamicSharedMemorySize, LDS_BYTES) != hipSuccess) { fprintf(stderr, "kernel_launch: hipFuncSetAttribute failed\n"); grid = -1; return; }
        if (hipOccupancyMaxActiveBlocksPerMultiprocessor(&per_cu, (const void*)hybrid_fwd, NTHREADS, LDS_BYTES) != hipSuccess || per_cu < 1) fprintf(stderr, "kernel_launch: occupancy query reports %d\n", per_cu);
        (void)hipGetLastError();
        grid = cus;
    }
    if (grid < 0) return;
    if (hipMemsetAsync((char*)d_ws + WS_CTL, 0, CTL_ZERO_BYTES, stream) != hipSuccess) return;
    Params p{};
    for (int i = 0; i < 20; ++i) p.in[i] = d_in[i];
    p.out = (float*)d_out; p.ws = (unsigned char*)d_ws;
#if N_LAUNCH_MODE == 1
    p.ph_lo = 0; p.ph_hi = NPH;
    hipLaunchKernelGGL(hybrid_fwd, dim3(grid), dim3(NTHREADS), LDS_BYTES, stream, p);
#else
    for (int k = 0; k < NPH; ++k) { p.ph_lo = k; p.ph_hi = k + 1; hipLaunchKernelGGL(hybrid_fwd, dim3(grid), dim3(NTHREADS), LDS_BYTES, stream, p); }
#endif
}
```

```cpp
#include <hip/hip_runtime.h>
#include <cstdio>
#include <cstdint>
#include <cmath>
namespace pg8 {
#define PG8_LAS __attribute__((address_space(3)))
typedef unsigned short bf16_t;
typedef short bf16x8 __attribute__((ext_vector_type(8)));
typedef float f32x4 __attribute__((ext_vector_type(4)));
typedef unsigned u32x4 __attribute__((ext_vector_type(4)));
typedef int i32x4_t __attribute__((ext_vector_type(4)));
typedef int i32x8_t __attribute__((ext_vector_type(8)));
constexpr int BM = 256, BK = 64, HALF = 128, HTB = HALF * BK * 2  , STAGE_BYTES = 8 * HTB, NXCD = 8, WGM = 8;

__host__ __device__ __forceinline__ int lds_byte(int r, int c) { const int st = (r >> 4) * 2 + (c >> 5), rr = r & 15, cc = c & 31, ob = rr * 64 + cc * 2; return st * 1024 + (ob ^ (((ob >> 9) & 1) << 5)); }
__host__ __device__ __forceinline__ void stage_rc(int b, int& R, int& C) { const int st = b / 1024, sb = b % 1024, swz = sb ^ (((sb >> 9) & 1) << 5); R = (st >> 1) * 16 + swz / 64; C = (st & 1) * 32 + (swz % 64) / 2; }
__host__ __device__ __forceinline__ int perm32(int rho) { const int n = rho >> 4, i = rho & 15; return 8 * (i >> 2) + 4 * n + (i & 3); }

struct Unit { int pm, pn, idx; };
struct Gemm { const bf16_t* A; const bf16_t* Bt; int M, N, K; int lda = 0, ldb = 0; };

struct StaticOrder {
    int nM, nN, nwg, G, c;
    __host__ __device__ void init(int M, int N, int G_, int c_) { nM = M / BM; nN = N / BM; nwg = nM * nN; G = G_; c = c_; }
    __host__ __device__ bool next(int i, Unit& u) const {
        const long L = (long)i * G + c; if (L >= nwg) return false;
        int wgid = (int)L; { const int q = nwg / NXCD, r = nwg % NXCD, xcd = wgid % NXCD, off = wgid / NXCD; wgid = (xcd < r ? xcd * (q + 1) : r * (q + 1) + (xcd - r) * q) + off; }
        const int nig = WGM * nN, gid = wgid / nig, fm = gid * WGM, gsz = (nM - fm) < WGM ? (nM - fm) : WGM;
        u.pm = fm + ((wgid % nig) % gsz); u.pn = (wgid % nig) / gsz; u.idx = i; return true;
    }
    __device__ __forceinline__ void a_ready(const Unit&) const {}
    __device__ __forceinline__ void done(const Unit&) const {}
};

__device__ __forceinline__ unsigned cvt_pk_bf16(float lo, float hi) { unsigned r; asm volatile("v_cvt_pk_bf16_f32 %0, %1, %2" : "=v"(r) : "v"(lo), "v"(hi)); return r; }
typedef float f32x2 __attribute__((ext_vector_type(2)));
__device__ __forceinline__ f32x2 gelu_pk(f32x2 v) {
    const f32x2 av = __builtin_elementwise_abs(v), d = av * 0.2316418882f + 1.0f;
    f32x2 t; t.x = __builtin_amdgcn_rcpf(d.x); t.y = __builtin_amdgcn_rcpf(d.y);
    f32x2 q = t * 0.5307027145f + (-0.7265760135f); q = q * t + 0.7107068705f; q = q * t + (-0.142248368f); q = q * t + 0.127414796f; q = q * t;
    const f32x2 s = (v * v) * (-0.72134752044f);
    f32x2 e; e.x = __builtin_amdgcn_exp2f(s.x); e.y = __builtin_amdgcn_exp2f(s.y);
    const f32x2 m = v * (q * e), r = v - m;
    f32x2 o; o.x = v.x < 0.f ? m.x : r.x; o.y = v.y < 0.f ? m.y : r.y; return o;
}

template <class Epi, class Sched, bool ALIGN_EPI = false, bool SP2 = false, bool F8 = false, int SCALE_B = 0x7F7F7F7F>
__device__ __forceinline__ void gemm_phase(PG8_LAS unsigned char* lds, const Gemm g, const Sched& S, const Epi& E) {
    int tid_ = threadIdx.x; asm volatile("" : "+v"(tid_));
    const int tid = tid_, wid = __builtin_amdgcn_readfirstlane(tid >> 6), lane = tid & 63, wr = wid >> 2, wc = wid & 3, fr = lane & 15, fq = lane >> 4;
    int K_ = g.K; asm volatile("" : "+s"(K_)); const int K = K_, nt = K / (F8 ? 2 * BK : BK); constexpr int ESZ = F8 ? 1 : 2;
    const int lda = g.lda ? g.lda : K, ldb = g.ldb ? g.ldb : K;
    unsigned voffA[2], voffB[2];
#pragma unroll
    for (int i = 0; i < 2; ++i) { int R, C; stage_rc(tid * 16 + i * 8192, R, C); const int Rb = Epi::PERM ? ((R & ~31) + perm32(R & 31)) : R;
        voffA[i] = F8 ? (unsigned)(R * lda + 2 * C) : (unsigned)(R * lda + C) * 2u; voffB[i] = F8 ? (unsigned)(Rb * ldb + 2 * C) : (unsigned)(Rb * ldb + C) * 2u; }
    const size_t kstep = (size_t)(BK * 2);
    const size_t hstepA = (size_t)HALF * lda * ESZ, hstepB = (size_t)HALF * ldb * ESZ;
    const size_t tstepA = 2 * hstepA, tstepB = 2 * hstepB;
    const unsigned ldsw = (unsigned)wid * 1024u;
    const int aoff = lds_byte(wr * 64 + fr, fq * 8), boff = lds_byte(wc * 32 + fr, fq * 8);
#define PG8_SA(b, h) (((b) * 2 + (h)) * HTB)
#define PG8_SB(b, h) ((4 + (b) * 2 + (h)) * HTB)
#define PG8_STAGE(bufoff, gbase, voff) do { _Pragma("unroll") for (int _i = 0; _i < 2; ++_i) \
        __builtin_amdgcn_global_load_lds((const unsigned*)((const char*)(gbase) + (voff)[_i]), (PG8_LAS unsigned*)(lds + (bufoff) + ldsw + _i * 8192), 16, 0, 0); } while (0)
#define PG8_LDA(dst, b, h) do { _Pragma("unroll") for (int m = 0; m < 4; ++m) _Pragma("unroll") for (int k = 0; k < 2; ++k) dst[m][k] = *(const PG8_LAS bf16x8*)(lds + PG8_SA(b, h) + aoff + m * 2048 + k * 1024); } while (0)
#define PG8_LDB(dst, b, h) do { _Pragma("unroll") for (int n = 0; n < 2; ++n) _Pragma("unroll") for (int k = 0; k < 2; ++k) dst[n][k] = *(const PG8_LAS bf16x8*)(lds + PG8_SB(b, h) + boff + n * 2048 + k * 1024); } while (0)
#define PG8_CAT8(x, y) __builtin_shufflevector(__builtin_bit_cast(i32x4_t, x), __builtin_bit_cast(i32x4_t, y), 0, 1, 2, 3, 4, 5, 6, 7)
#define PG8_MMA(ai, bj, At, Bt) do { __builtin_amdgcn_s_setprio(1); if constexpr (F8) { i32x8_t a8_[4], b8_[2]; _Pragma("unroll") for (int m = 0; m < 4; ++m) a8_[m] = PG8_CAT8(At[m][0], At[m][1]); _Pragma("unroll") for (int n = 0; n < 2; ++n) b8_[n] = PG8_CAT8(Bt[n][0], Bt[n][1]); \
        _Pragma("unroll") for (int m = 0; m < 4; ++m) _Pragma("unroll") for (int n = 0; n < 2; ++n) \
        asm volatile("v_mfma_scale_f32_16x16x128_f8f6f4 %0, %1, %2, %0, %3, %4 op_sel_hi:[0,0,0]" : "+v"(acc[ai][bj][m][n]) : "v"(b8_[n]), "v"(a8_[m]), "v"(sclB_), "v"(sclA_)); } \
    else { _Pragma("unroll") for (int m = 0; m < 4; ++m) _Pragma("unroll") for (int n = 0; n < 2; ++n) _Pragma("unroll") for (int k = 0; k < 2; ++k) \
        acc[ai][bj][m][n] = __builtin_amdgcn_mfma_f32_16x16x32_bf16(Bt[n][k], At[m][k], acc[ai][bj][m][n], 0, 0, 0); } __builtin_amdgcn_s_setprio(0); } while (0)
#define PG8_WAIT_V(n) asm volatile("s_waitcnt vmcnt(" #n ")" ::: "memory")
#define PG8_WAIT_L(n) asm volatile("s_waitcnt lgkmcnt(" #n ")" ::: "memory")
#define PG8_BAR __builtin_amdgcn_s_barrier()
#define PG8_SCHED __builtin_amdgcn_sched_barrier(0)
    int sclA_ = 0x7F7F7F7F, sclB_ = SCALE_B; if constexpr (F8) { asm volatile("" : "+v"(sclA_), "+v"(sclB_)); }
    Unit cur, nxt; int ui = 0;
    if (!S.next(0, cur)) return;
    f32x4 acc[2][2][4][2];
#pragma unroll
    for (int a = 0; a < 2; ++a)
#pragma unroll
        for (int b = 0; b < 2; ++b)
#pragma unroll
            for (int m = 0; m < 4; ++m)
#pragma unroll
                for (int n = 0; n < 2; ++n) acc[a][b][m][n] = (f32x4){0.f, 0.f, 0.f, 0.f};
    bf16x8 At[4][2], B0[2][2], B1[2][2];
    const char* cA = (const char*)g.A + (size_t)cur.pm * tstepA; const char* cB = (const char*)g.Bt + (size_t)cur.pn * tstepB;
    S.a_ready(cur);
    if constexpr (SP2) {
        PG8_STAGE(PG8_SB(0, 0), cB, voffB); PG8_STAGE(PG8_SB(0, 1), cB + hstepB, voffB); PG8_STAGE(PG8_SA(0, 0), cA, voffA); PG8_STAGE(PG8_SA(0, 1), cA + hstepA, voffA);
        if (wr == 1) PG8_BAR;
        PG8_WAIT_V(2); PG8_BAR;
        PG8_STAGE(PG8_SB(1, 0), cB + kstep, voffB); PG8_STAGE(PG8_SA(1, 0), cA + kstep, voffA); PG8_STAGE(PG8_SB(1, 1), cB + hstepB + kstep, voffB);
        PG8_WAIT_V(6); PG8_BAR;
    } else {
        PG8_STAGE(PG8_SB(0, 0), cB, voffB); PG8_STAGE(PG8_SA(0, 0), cA, voffA); PG8_STAGE(PG8_SB(0, 1), cB + hstepB, voffB); PG8_STAGE(PG8_SA(0, 1), cA + hstepA, voffA);
        if (wr == 1) PG8_BAR;
        PG8_WAIT_V(4); PG8_BAR;
        PG8_STAGE(PG8_SB(1, 0), cB + kstep, voffB); PG8_STAGE(PG8_SA(1, 0), cA + kstep, voffA); PG8_STAGE(PG8_SB(1, 1), cB + hstepB + kstep, voffB);
        PG8_WAIT_V(6); PG8_BAR;
    }
    for (;;) {
        const bool has_next = S.next(ui + 1, nxt);
        const char* nA = has_next ? (const char*)g.A + (size_t)nxt.pm * tstepA : cA; const char* nB = has_next ? (const char*)g.Bt + (size_t)nxt.pn * tstepB : cB;
        for (int t = 0; t < nt; t += 2) {
            const bool last = (t == nt - 2);
            const char* a1 = cA + (size_t)(t + 1) * kstep;
            const char* a2 = last ? nA : cA + (size_t)(t + 2) * kstep; const char* b2 = last ? nB : cB + (size_t)(t + 2) * kstep;
            const char* a3 = a2 + kstep; const char* b3 = b2 + kstep;
            if (last && has_next) S.a_ready(nxt);
            if constexpr (SP2) {
            PG8_LDB(B0, 0, 0); PG8_LDB(B1, 0, 1); PG8_SCHED; PG8_LDA(At, 0, 0); PG8_STAGE(PG8_SA(1, 1), a1 + hstepA, voffA);
            PG8_WAIT_V(8); PG8_WAIT_L(0); PG8_BAR; PG8_MMA(0, 0, At, B0); PG8_MMA(0, 1, At, B1); PG8_BAR; PG8_SCHED;
            PG8_LDA(At, 0, 1); PG8_STAGE(PG8_SB(0, 0), b2, voffB); PG8_STAGE(PG8_SB(0, 1), b2 + hstepB, voffB); PG8_STAGE(PG8_SA(0, 0), a2, voffA);
            PG8_WAIT_V(8); PG8_WAIT_L(0); PG8_BAR; PG8_MMA(1, 0, At, B0); PG8_MMA(1, 1, At, B1); PG8_BAR; PG8_SCHED;
            PG8_LDB(B0, 1, 0); PG8_LDB(B1, 1, 1); PG8_SCHED; PG8_LDA(At, 1, 0); PG8_STAGE(PG8_SA(0, 1), a2 + hstepA, voffA);
            PG8_WAIT_V(8); PG8_WAIT_L(0); PG8_BAR; PG8_MMA(0, 0, At, B0); PG8_MMA(0, 1, At, B1); PG8_BAR; PG8_SCHED;
            PG8_LDA(At, 1, 1); PG8_STAGE(PG8_SB(1, 0), b3, voffB); PG8_STAGE(PG8_SB(1, 1), b3 + hstepB, voffB); PG8_STAGE(PG8_SA(1, 0), a3, voffA);
            PG8_WAIT_V(8); PG8_WAIT_L(0); PG8_BAR; PG8_MMA(1, 0, At, B0); PG8_MMA(1, 1, At, B1); PG8_BAR; PG8_SCHED;
            } else {
            PG8_LDB(B0, 0, 0); PG8_SCHED; PG8_LDA(At, 0, 0); PG8_STAGE(PG8_SA(1, 1), a1 + hstepA, voffA);
            PG8_WAIT_L(8); PG8_BAR; PG8_WAIT_L(0); PG8_MMA(0, 0, At, B0); PG8_BAR; PG8_SCHED;
            PG8_LDB(B1, 0, 1); PG8_STAGE(PG8_SB(0, 0), b2, voffB);
            PG8_BAR; PG8_WAIT_L(0); PG8_MMA(0, 1, At, B1); PG8_BAR;
            PG8_LDA(At, 0, 1); PG8_STAGE(PG8_SA(0, 0), a2, voffA);
            PG8_BAR; PG8_WAIT_L(0); PG8_MMA(1, 0, At, B0); PG8_BAR; PG8_SCHED;
            PG8_STAGE(PG8_SB(0, 1), b2 + hstepB, voffB);
            PG8_WAIT_V(6); PG8_BAR; PG8_MMA(1, 1, At, B1); PG8_BAR;
            PG8_LDB(B0, 1, 0); PG8_SCHED; PG8_LDA(At, 1, 0); PG8_STAGE(PG8_SA(0, 1), a2 + hstepA, voffA);
            PG8_WAIT_L(8); PG8_BAR; PG8_WAIT_L(0); PG8_MMA(0, 0, At, B0); PG8_BAR; PG8_SCHED;
            PG8_LDB(B1, 1, 1); PG8_STAGE(PG8_SB(1, 0), b3, voffB);
            PG8_BAR; PG8_WAIT_L(0); PG8_MMA(0, 1, At, B1); PG8_BAR;
            PG8_LDA(At, 1, 1); PG8_STAGE(PG8_SA(1, 0), a3, voffA);
            PG8_BAR; PG8_WAIT_L(0); PG8_MMA(1, 0, At, B0); PG8_BAR; PG8_SCHED;
            PG8_STAGE(PG8_SB(1, 1), b3 + hstepB, voffB);
            PG8_WAIT_V(6); PG8_BAR; PG8_MMA(1, 1, At, B1); PG8_BAR;
            }
        }
        if constexpr (F8) asm volatile("s_nop 15\n\ts_nop 15" ::: "memory");
        if constexpr (ALIGN_EPI) { if (wr == 0) PG8_BAR; }
        if constexpr (!Epi::AFTER_DRAIN) { E(acc, cur, wr, wc, fr, fq);
#ifdef DOUBLE_EPI
            if constexpr (Epi::IDEMPOTENT) { asm volatile("" ::: "memory"); E(acc, cur, wr, wc, fr, fq); }
#endif
            S.done(cur); }
        if (!has_next) break;
#pragma unroll
        for (int a = 0; a < 2; ++a)
#pragma unroll
            for (int b = 0; b < 2; ++b)
#pragma unroll
                for (int m = 0; m < 4; ++m)
#pragma unroll
                    for (int n = 0; n < 2; ++n) acc[a][b][m][n] = (f32x4){0.f, 0.f, 0.f, 0.f};
        cur = nxt; cA = nA; cB = nB; ++ui;
        if constexpr (ALIGN_EPI) { if (wr == 1) PG8_BAR; }
    }
    PG8_WAIT_V(0);
    if constexpr (!ALIGN_EPI) { if (wr == 0) PG8_BAR; }
    PG8_BAR;
    if constexpr (Epi::AFTER_DRAIN) { E.fused(acc, cur, wr, wc, fr, fq, lds, wid, lane); S.done(cur); }
#undef PG8_SA
#undef PG8_SB
#undef PG8_STAGE
#undef PG8_LDA
#undef PG8_LDB
#undef PG8_MMA
#undef PG8_CAT8
#undef PG8_WAIT_V
#undef PG8_WAIT_L
#undef PG8_BAR
#undef PG8_SCHED
}
}
namespace pg8 {
struct Gemm2 { const unsigned char* A; const unsigned char* B; int LD, OFF8, K8, K16; };
template <class Epi, class Sched, int SCALE_B>
__device__ __forceinline__ void gemm_phase_mixed(PG8_LAS unsigned char* lds, const Gemm2 g, const Sched& S, const Epi& E) {
    int tid_ = threadIdx.x; asm volatile("" : "+v"(tid_));
    const int tid = tid_, wid = __builtin_amdgcn_readfirstlane(tid >> 6), lane = tid & 63, wr = wid >> 2, wc = wid & 3, fr = lane & 15, fq = lane >> 4;
    int K8_ = g.K8, K16_ = g.K16; asm volatile("" : "+s"(K8_), "+s"(K16_)); const int n8 = K8_ / 128, n16 = K16_ / 64, NT = n8 + n16, LD = g.LD, O8 = g.OFF8;
    unsigned voffA[2], voffB[2];
#pragma unroll
    for (int i = 0; i < 2; ++i) { int R, C; stage_rc(tid * 16 + i * 8192, R, C); const int Rb = Epi::PERM ? ((R & ~31) + perm32(R & 31)) : R;
        voffA[i] = (unsigned)(R * LD + 2 * C); voffB[i] = (unsigned)(Rb * LD + 2 * C); }
    const size_t hstep = (size_t)HALF * LD, tstep = 2 * hstep;
    const unsigned ldsw = (unsigned)wid * 1024u;
    const int aoff = lds_byte(wr * 64 + fr, fq * 8), boff = lds_byte(wc * 32 + fr, fq * 8);
#define PG8_SA(b, h) (((b) * 2 + (h)) * HTB)
#define PG8_SB(b, h) ((4 + (b) * 2 + (h)) * HTB)
#define PG8_STAGE(bufoff, gbase, voff) do { _Pragma("unroll") for (int _i = 0; _i < 2; ++_i) \
        __builtin_amdgcn_global_load_lds((const unsigned*)((const char*)(gbase) + (voff)[_i]), (PG8_LAS unsigned*)(lds + (bufoff) + ldsw + _i * 8192), 16, 0, 0); } while (0)
#define PG8_LDA(dst, b, h) do { _Pragma("unroll") for (int m = 0; m < 4; ++m) _Pragma("unroll") for (int k = 0; k < 2; ++k) dst[m][k] = *(const PG8_LAS bf16x8*)(lds + PG8_SA(b, h) + aoff + m * 2048 + k * 1024); } while (0)
#define PG8_LDB(dst, b, h) do { _Pragma("unroll") for (int n = 0; n < 2; ++n) _Pragma("unroll") for (int k = 0; k < 2; ++k) dst[n][k] = *(const PG8_LAS bf16x8*)(lds + PG8_SB(b, h) + boff + n * 2048 + k * 1024); } while (0)
#define PG8_CAT8(x, y) __builtin_shufflevector(__builtin_bit_cast(i32x4_t, x), __builtin_bit_cast(i32x4_t, y), 0, 1, 2, 3, 4, 5, 6, 7)
#define PG8_MMA8(ai, bj, At, Bt) do { __builtin_amdgcn_s_setprio(1); { i32x8_t a8_[4], b8_[2]; _Pragma("unroll") for (int m = 0; m < 4; ++m) a8_[m] = PG8_CAT8(At[m][0], At[m][1]); _Pragma("unroll") for (int n = 0; n < 2; ++n) b8_[n] = PG8_CAT8(Bt[n][0], Bt[n][1]); \
        _Pragma("unroll") for (int m = 0; m < 4; ++m) _Pragma("unroll") for (int n = 0; n < 2; ++n) \
        asm volatile("v_mfma_scale_f32_16x16x128_f8f6f4 %0, %1, %2, %0, %3, %4 op_sel_hi:[0,0,0]" : "+v"(acc[ai][bj][m][n]) : "v"(b8_[n]), "v"(a8_[m]), "v"(sclB_), "v"(sclA_)); } __builtin_amdgcn_s_setprio(0); } while (0)
#define PG8_MMA16(ai, bj, At, Bt) do { __builtin_amdgcn_s_setprio(1); _Pragma("unroll") for (int m = 0; m < 4; ++m) _Pragma("unroll") for (int n = 0; n < 2; ++n) _Pragma("unroll") for (int k = 0; k < 2; ++k) \
        asm volatile("v_mfma_f32_16x16x32_bf16 %0, %1, %2, %0" : "+v"(acc[ai][bj][m][n]) : "v"(Bt[n][k]), "v"(At[m][k])); __builtin_amdgcn_s_setprio(0); } while (0)
#define PG8_WAIT_V(n) asm volatile("s_waitcnt vmcnt(" #n ")" ::: "memory")
#define PG8_WAIT_L(n) asm volatile("s_waitcnt lgkmcnt(" #n ")" ::: "memory")
#define PG8_BAR __builtin_amdgcn_s_barrier()
#define PG8_SCHED __builtin_amdgcn_sched_barrier(0)
#define PG8_BODY(MMA) do { \
            PG8_LDB(B0, 0, 0); PG8_LDB(B1, 0, 1); PG8_SCHED; PG8_LDA(At, 0, 0); PG8_STAGE(PG8_SA(1, 1), a1 + hstep, voffA); \
            PG8_WAIT_V(8); PG8_WAIT_L(0); PG8_BAR; MMA(0, 0, At, B0); MMA(0, 1, At, B1); PG8_BAR; PG8_SCHED; \
            PG8_LDA(At, 0, 1); PG8_STAGE(PG8_SB(0, 0), b2, voffB); PG8_STAGE(PG8_SB(0, 1), b2 + hstep, voffB); PG8_STAGE(PG8_SA(0, 0), a2, voffA); \
            PG8_WAIT_V(8); PG8_WAIT_L(0); PG8_BAR; MMA(1, 0, At, B0); MMA(1, 1, At, B1); PG8_BAR; PG8_SCHED; \
            PG8_LDB(B0, 1, 0); PG8_LDB(B1, 1, 1); PG8_SCHED; PG8_LDA(At, 1, 0); PG8_STAGE(PG8_SA(0, 1), a2 + hstep, voffA); \
            PG8_WAIT_V(8); PG8_WAIT_L(0); PG8_BAR; MMA(0, 0, At, B0); MMA(0, 1, At, B1); PG8_BAR; PG8_SCHED; \
            PG8_LDA(At, 1, 1); PG8_STAGE(PG8_SB(1, 0), b3, voffB); PG8_STAGE(PG8_SB(1, 1), b3 + hstep, voffB); PG8_STAGE(PG8_SA(1, 0), a3, voffA); \
            PG8_WAIT_V(8); PG8_WAIT_L(0); PG8_BAR; MMA(1, 0, At, B0); MMA(1, 1, At, B1); PG8_BAR; PG8_SCHED; } while (0)
    int sclA_ = 0x7F7F7F7F, sclB_ = SCALE_B; asm volatile("" : "+v"(sclA_), "+v"(sclB_));
    Unit cur, nxt; int ui = 0;
    if (!S.next(0, cur)) return;
    f32x4 acc[2][2][4][2];
#pragma unroll
    for (int a = 0; a < 2; ++a)
#pragma unroll
        for (int b = 0; b < 2; ++b)
#pragma unroll
            for (int m = 0; m < 4; ++m)
#pragma unroll
                for (int n = 0; n < 2; ++n) acc[a][b][m][n] = (f32x4){0.f, 0.f, 0.f, 0.f};
    bf16x8 At[4][2], B0[2][2], B1[2][2];
    const char* cA = (const char*)g.A + (size_t)cur.pm * tstep; const char* cB = (const char*)g.B + (size_t)cur.pn * tstep;
    PG8_STAGE(PG8_SB(0, 0), cB + O8, voffB); PG8_STAGE(PG8_SB(0, 1), cB + O8 + hstep, voffB); PG8_STAGE(PG8_SA(0, 0), cA + O8, voffA); PG8_STAGE(PG8_SA(0, 1), cA + O8 + hstep, voffA);
    if (wr == 1) PG8_BAR;
    PG8_WAIT_V(2); PG8_BAR;
    PG8_STAGE(PG8_SB(1, 0), cB + O8 + 128, voffB); PG8_STAGE(PG8_SA(1, 0), cA + O8 + 128, voffA); PG8_STAGE(PG8_SB(1, 1), cB + O8 + hstep + 128, voffB);
    PG8_WAIT_V(6); PG8_BAR;
    for (;;) {
        const bool has_next = S.next(ui + 1, nxt);
        const char* nA = has_next ? (const char*)g.A + (size_t)nxt.pm * tstep : cA; const char* nB = has_next ? (const char*)g.B + (size_t)nxt.pn * tstep : cB;
#pragma clang loop unroll(disable)
        for (int t = 0; t < n8; t += 2) {
            const char* a1 = cA + O8 + (size_t)(t + 1) * 128;
            const bool lastf = (t + 2 >= n8);
            const char* a2 = lastf ? cA : cA + O8 + (size_t)(t + 2) * 128; const char* b2 = lastf ? cB : cB + O8 + (size_t)(t + 2) * 128;
            const char* a3 = a2 + 128; const char* b3 = b2 + 128;
            PG8_BODY(PG8_MMA8);
        }
#pragma clang loop unroll(disable)
        for (int t = 0; t < n16; t += 2) {
            const char* a1 = cA + (size_t)(t + 1) * 128;
            const bool lastb = (t + 2 >= n16);
            const char* a2 = lastb ? nA + O8 : cA + (size_t)(t + 2) * 128; const char* b2 = lastb ? nB + O8 : cB + (size_t)(t + 2) * 128;
            const char* a3 = a2 + 128; const char* b3 = b2 + 128;
            PG8_BODY(PG8_MMA16);
        }
        asm volatile("s_nop 15\n\ts_nop 15" ::: "memory");
        if (wr == 0) PG8_BAR;
        E(acc, cur, wr, wc, fr, fq);
        if (!has_next) break;
#pragma unroll
        for (int a = 0; a < 2; ++a)
#pragma unroll
            for (int b = 0; b < 2; ++b)
#pragma unroll
                for (int m = 0; m < 4; ++m)
#pragma unroll
                    for (int n = 0; n < 2; ++n) acc[a][b][m][n] = (f32x4){0.f, 0.f, 0.f, 0.f};
        cur = nxt; cA = nA; cB = nB; ++ui;
        if (wr == 1) PG8_BAR;
    }
    PG8_WAIT_V(0);
    PG8_BAR;
#undef PG8_SA
#undef PG8_SB
#undef PG8_STAGE
#undef PG8_BODY
#undef PG8_MMA8
#undef PG8_MMA16
#undef PG8_LDA
#undef PG8_LDB
#undef PG8_CAT8
#undef PG8_WAIT_V
#undef PG8_WAIT_L
#undef PG8_BAR
#undef PG8_SCHED
}
}

constexpr int NB = 2, SEQ = 4096, DM = 4096, MROWS = NB * SEQ, HD = 128, NHB = 92, NPROJ = 12032, NIN = 11808, DFF = 16384, PLE = 256, DEPTH = 2;
constexpr int NCMP = 255;
constexpr float RMS_EPS = 1e-6f;
constexpr float QK_SCALE = 0.08838834764831845f;
constexpr int NWAVES = 8, NTHREADS = 512;
constexpr int HB_QA = 0, HB_KC = 8, HB_VC = 10, HB_KS = 12, HB_VS = 14, HB_KW = 16, HB_VW = 18, HB_QB = 20, HB_KB = 28, HB_VB = 36, HB_QC = 44, HB_KCC = 52, HB_VCC = 60, HB_QD = 68, HB_KD = 76, HB_VD = 84;
__host__ __device__ __forceinline__ bool hb_is_rope(int hb) { return hb < 8 || hb == 12 || hb == 13 || hb == 16 || hb == 17 || (hb >= 44 && hb < 60); }

constexpr size_t MiB = 1u << 20;
constexpr size_t WS_CTL = 0, CTL_ZERO_BYTES = 1 * MiB;
constexpr size_t WS_ROPE = 1 * MiB;
constexpr size_t WS_GATE = 6 * MiB;
constexpr size_t WS_CUM = 7 * MiB;
constexpr size_t WS_KC = 8 * MiB;
constexpr size_t WS_VC = 8 * MiB + 512 * 1024;
constexpr size_t WS_SSA = 12 * MiB, WS_SSB = 14 * MiB;
constexpr size_t WS_CBP = 11 * MiB;
constexpr size_t WS_HID = 10 * MiB;
constexpr size_t WS_SEL = 9 * MiB;
constexpr size_t WS_PB = 16 * MiB;
constexpr size_t WS_W = 32 * MiB;
constexpr size_t W_IN = 0, W_O = 94 * MiB, W_UP = 126 * MiB, W_DN = 254 * MiB, W_G = 382 * MiB, W_PP = 414 * MiB, W_C1K = 416 * MiB, W_C1V = 418 * MiB, W_C2K = 420 * MiB, W_C2V = 420 * MiB + 65536, LAYER_W = 424 * MiB;
constexpr size_t WS_XN = 896 * MiB;
constexpr size_t WS_QKV = 960 * MiB;
constexpr size_t WS_OCMP = 1144 * MiB;
constexpr size_t WS_MIX = 1176 * MiB;
constexpr int MIXLD = 6144, MIXO8 = 4096;
constexpr size_t WS_H = 1240 * MiB;
constexpr size_t WS_FF = 1368 * MiB;
constexpr size_t WS_XN8 = WS_FF;
constexpr size_t WS_PP = 1624 * MiB;
constexpr size_t WS_DO = 1688 * MiB;
constexpr size_t WS_LSE = 1784 * MiB;
constexpr size_t WS_OS = 1785 * MiB;
constexpr size_t WS_XN2 = 1817 * MiB;
constexpr size_t WS_END = 1881 * MiB;
static_assert(WS_W + 2 * LAYER_W <= WS_XN, "ws map");
static_assert((size_t)NPROJ * DM * 2 <= W_O, "ws map");
constexpr int N8P = 31, N16P = 16;
__constant__ unsigned char P8MAP[N8P] = {0,1,2,3,4,5,6,7,8,9,10,11,12,13,14,15,16,17,22,23,24,25,26,27,28,29,30,31,32,33,46};
__constant__ unsigned char P16MAP[N16P] = {18,19,20,21,34,35,36,37,38,39,40,41,42,43,44,45};
__constant__ unsigned char PTYPE[47] = {128,129,130,131,132,133,134,135,136,137,138,139,140,141,142,143,144,145,0,1,2,3,146,147,148,149,150,151,152,153,154,155,156,157,4,5,6,7,8,9,10,11,12,13,14,15,158};
constexpr size_t W_IN8 = 52 * MiB;
static_assert((size_t)N16P * 256 * 4096 * 2 <= W_IN8 && W_IN8 + (size_t)N8P * 256 * 4096 <= W_O, "w_in split");
constexpr int CW_BAR = 4096, CW_CBIAS = 16384;

constexpr int RING_OFF = 0, RING_BYTES = 131072;
constexpr int LDSCTL_OFF = RING_BYTES, MISC_OFF = LDSCTL_OFF + 320;
constexpr int LDS_BYTES = 147456;

#define GAS __attribute__((address_space(1)))
#define LAS __attribute__((address_space(3)))
typedef unsigned short bf16;
typedef unsigned v4u __attribute__((ext_vector_type(4)));
typedef unsigned v2u __attribute__((ext_vector_type(2)));
typedef float f32x4 __attribute__((ext_vector_type(4)));
typedef float f32x2 __attribute__((ext_vector_type(2)));
#define LDS_WAIT() asm volatile("s_waitcnt lgkmcnt(0)" ::: "memory")
#define VM_WAIT() asm volatile("s_waitcnt vmcnt(0)" ::: "memory")
__device__ __forceinline__ unsigned f2bf(float f) { unsigned u = __builtin_bit_cast(unsigned, f); return (u + 0x7fffu + ((u >> 16) & 1u)) >> 16; }
__device__ __forceinline__ unsigned pk2(float lo, float hi) { return f2bf(lo) | (f2bf(hi) << 16); }
__device__ __forceinline__ float bflo(unsigned u) { return __builtin_bit_cast(float, u << 16); }
__device__ __forceinline__ float bfhi(unsigned u) { return __builtin_bit_cast(float, u & 0xffff0000u); }
__device__ __forceinline__ unsigned pk4_fp8(float a, float b, float c, float d) { int v = __builtin_amdgcn_cvt_pk_fp8_f32(a, b, 0, false); v = __builtin_amdgcn_cvt_pk_fp8_f32(c, d, v, true); return (unsigned)v; }
__device__ __forceinline__ float wave_sum(float v) {
#pragma unroll
    for (int o = 1; o < 64; o <<= 1) v += __shfl_xor(v, o);
    return v;
}
__device__ __forceinline__ float wave_max(float v) {
#pragma unroll
    for (int o = 1; o < 64; o <<= 1) v = fmaxf(v, __shfl_xor(v, o));
    return v;
}
__device__ __forceinline__ float sigmoidf_(float x) { return 1.0f / (1.0f + __expf(-x)); }

#define XB_TMO      128
#define XB_XCNT(j)  (256  + 64 * (j))
#define XB_XSUB(j)  (1280 + 64 * (j))
#define XB_XGEN(j)  (2304 + 64 * (j))
#define XB_TOP      3328
#define XB_TOPGEN   3392
#define XCD_BAR_WORDS 3456
#define XB_SPIN_CAP (1u << 18)

__device__ __forceinline__ unsigned xb_ld(unsigned* p)              { return __hip_atomic_load(p, __ATOMIC_RELAXED, __HIP_MEMORY_SCOPE_AGENT); }
__device__ __forceinline__ unsigned xb_add(unsigned* p, unsigned v) { return __hip_atomic_fetch_add(p, v, __ATOMIC_RELAXED, __HIP_MEMORY_SCOPE_AGENT); }
__device__ __forceinline__ unsigned xb_xcc_id() { return (unsigned)__builtin_amdgcn_s_getreg((3 << 11) | 20) & 0xFu; }
#define XB_SPIN(cond, bar) do { unsigned _sp = 0; while (cond) { __builtin_amdgcn_s_sleep(1); \
    if ((++_sp & 255u) == 0u) { if (xb_ld(&(bar)[XB_TMO])) break; if (_sp > XB_SPIN_CAP) { atomicAdd(&(bar)[XB_TMO], 1u); break; } } } } while (0)

struct XcdBarrier {
    unsigned* bar; unsigned x;
    volatile LAS unsigned* st;
};

__device__ __forceinline__ XcdBarrier xcd_barrier_post(unsigned* bar, volatile LAS unsigned* st) {
    XcdBarrier b; b.bar = bar; b.x = xb_xcc_id(); b.st = st;
    if (threadIdx.x == 0) (void)xb_add(&bar[XB_XCNT(b.x)], 1u);
    return b;
}
__device__ __forceinline__ void xcd_barrier_complete(unsigned* bar, unsigned x, unsigned& nloc, unsigned& nx) {
    const unsigned G = gridDim.x * gridDim.y * gridDim.z;
    unsigned sum, cnt, mine, sp = 0u;
    for (;;) {
        sum = 0u; cnt = 0u; mine = 0u;
#pragma unroll
        for (unsigned j = 0; j < 16; ++j) { const unsigned c = xb_ld(&bar[XB_XCNT(j)]); sum += c; cnt += (c > 0u) ? 1u : 0u; mine = (j == x) ? c : mine; }
        if (sum == G) break;
        __builtin_amdgcn_s_sleep(1);
        if ((++sp & 255u) == 0u) { if (xb_ld(&bar[XB_TMO])) break; if (sp > XB_SPIN_CAP) { atomicAdd(&bar[XB_TMO], 1u); break; } }
    }
    nloc = mine > 0u ? mine : 1u; nx = cnt > 0u ? cnt : 1u;
}

__device__ __forceinline__ void xcd_barrier(const XcdBarrier& b) {
    asm volatile("s_waitcnt vmcnt(0)" ::: "memory");
    __syncthreads();
    if (threadIdx.x == 0) {
        unsigned* bar = b.bar;
        __builtin_amdgcn_s_waitcnt(0);
        unsigned nloc = b.st[0], nx = b.st[1];
        if (nloc == 0u) { xcd_barrier_complete(bar, b.x, nloc, nx); b.st[0] = nloc; b.st[1] = nx; }
        const unsigned old = xb_add(&bar[XB_XSUB(b.x)], 1u);
        const unsigned gen = old / nloc;
        if (old + 1u == (gen + 1u) * nloc) {
            __builtin_amdgcn_fence(__ATOMIC_RELEASE, "agent");
            asm volatile("s_waitcnt vmcnt(0)" ::: "memory");
            const unsigned og = xb_add(&bar[XB_TOP], 1u);
            const unsigned tg = og / nx;
            if (og + 1u == (tg + 1u) * nx) xb_add(&bar[XB_TOPGEN], 1u);
            else XB_SPIN(xb_ld(&bar[XB_TOPGEN]) == tg, bar);
            __builtin_amdgcn_fence(__ATOMIC_ACQUIRE, "agent");
            xb_add(&bar[XB_XGEN(b.x)], 1u);
            asm volatile("s_waitcnt vmcnt(0)" ::: "memory");
        } else {
            XB_SPIN(xb_ld(&bar[XB_XGEN(b.x)]) == gen, bar);
            __builtin_amdgcn_fence(__ATOMIC_ACQUIRE, "agent");
            asm volatile("s_waitcnt vmcnt(0)" ::: "memory");
        }
    }
    __syncthreads();
}

namespace pg8 {
__device__ __forceinline__ void row_rstd(const float* SS, int row0, int fq, float (&rs)[2][4]) {
#pragma unroll
    for (int ai = 0; ai < 2; ++ai)
#pragma unroll
        for (int m = 0; m < 4; ++m) { const f32x4* sp = (const f32x4*)(SS + (size_t)(row0 + ai * HALF + m * 16) * 64 + 16 * fq);
            const f32x4 a = sp[0], b = sp[1], c = sp[2], d = sp[3];
            float s = (((a[0] + a[1]) + (a[2] + a[3])) + ((b[0] + b[1]) + (b[2] + b[3]))) + (((c[0] + c[1]) + (c[2] + c[3])) + ((d[0] + d[1]) + (d[2] + d[3])));
            s += __shfl_xor(s, 16); s += __shfl_xor(s, 32);
            rs[ai][m] = 1.0f / sqrtf(s * (1.0f / 4096.0f) + 1e-6f); }
}
__device__ __forceinline__ float row_rstd1(const float* SS, int row, int fq) {
    const f32x4* sp = (const f32x4*)(SS + (size_t)row * 64 + 16 * fq);
    const f32x4 a = sp[0], b = sp[1], c = sp[2], d = sp[3];
    float s = (((a[0] + a[1]) + (a[2] + a[3])) + ((b[0] + b[1]) + (b[2] + b[3]))) + (((c[0] + c[1]) + (c[2] + c[3])) + ((d[0] + d[1]) + (d[2] + d[3])));
    s += __shfl_xor(s, 16); s += __shfl_xor(s, 32);
    return 1.0f / sqrtf(s * (1.0f / 4096.0f) + 1e-6f);
}
template <bool RSTD, bool P8> struct EpiProj {
    static constexpr bool PERM = true, AFTER_DRAIN = false, IDEMPOTENT = true;
    bf16_t* QKV; float* GATE; const float* cs; const PG8_LAS float* lr;
    __device__ __forceinline__ void operator()(const f32x4 (&acc)[2][2][4][2], const Unit& u, int wr, int wc, int fr, int fq) const {
        const int row0 = u.pm * BM + wr * 64 + fr;
        typedef unsigned u32x2 __attribute__((ext_vector_type(2)));
        const int pn_ = P8 ? P8MAP[u.pn] : P16MAP[u.pn];
        const bool gate = (pn_ == 46);
        const int hb0 = 2 * pn_; const bool rope0 = !gate && hb_is_rope(hb0), rope1 = !gate && hb_is_rope(hb0 + 1);
        const int e0 = 16 * wc + 4 * fq;
#pragma unroll
        for (int ai = 0; ai < 2; ++ai)
#pragma unroll
            for (int m = 0; m < 4; ++m) { const int row = row0 + ai * HALF + m * 16;
                const float rs = RSTD ? lr[u.idx * 256 + (row - u.pm * BM)] : 1.f;
                if (gate) { if (wc == 0) { float* gp = GATE + (size_t)row * 32 + 8 * fq; *(f32x4*)gp = acc[ai][0][m][0] * rs; *(f32x4*)(gp + 4) = acc[ai][0][m][1] * rs; } }
                else {
#pragma unroll
                    for (int bj = 0; bj < 2; ++bj) { bf16_t* base = QKV + (size_t)(hb0 + bj) * ((size_t)MROWS * HD) + (size_t)row * HD;
                        const f32x4 v0 = acc[ai][bj][m][0] * rs, v1 = acc[ai][bj][m][1] * rs;
                        if (bj == 0 ? rope0 : rope1) {
                            const f32x4 c = *(const f32x4*)(cs + (size_t)row * 64 + e0), s = *(const f32x4*)(cs + (size_t)MROWS * 64 + (size_t)row * 64 + e0);
                            const f32x4 o0 = v0 * c - v1 * s, o1 = v1 * c + v0 * s;
                            u32x2 w0, w1; w0.x = cvt_pk_bf16(o0[0], o0[1]); w0.y = cvt_pk_bf16(o0[2], o0[3]); w1.x = cvt_pk_bf16(o1[0], o1[1]); w1.y = cvt_pk_bf16(o1[2], o1[3]);
                            *(u32x2*)(base + e0) = w0; *(u32x2*)(base + e0 + 64) = w1;
                        } else {
                            u32x4 w; w.x = cvt_pk_bf16(v0[0], v0[1]); w.y = cvt_pk_bf16(v0[2], v0[3]); w.z = cvt_pk_bf16(v1[0], v1[1]); w.w = cvt_pk_bf16(v1[2], v1[3]);
                            *(u32x4*)(base + wc * 32 + 8 * fq) = w; } } }
                if (m & 1) asm volatile("" ::: "memory"); }
    }
};
template <bool SRC32, bool F8OUT> struct EpiResid {
    static constexpr bool PERM = true, AFTER_DRAIN = false, IDEMPOTENT = false;
    const void* src; bf16_t* dst; int ldc; unsigned char* XN8; float* SS;
    __device__ __forceinline__ void operator()(const f32x4 (&acc)[2][2][4][2], const Unit& u, int wr, int wc, int fr, int fq) const {
        const int row0 = u.pm * BM + wr * 64 + fr, col0 = u.pn * BM + wc * 32 + 8 * fq;
#pragma unroll
        for (int ai = 0; ai < 2; ++ai)
#pragma unroll
            for (int m = 0; m < 4; ++m) { const int row = row0 + ai * HALF + m * 16; const size_t off = (size_t)row * ldc + col0; float ss = 0.f;
#pragma unroll
                for (int bj = 0; bj < 2; ++bj) { f32x4 s0, s1;
                    if (SRC32) { const float* sp = (const float*)src + off + bj * HALF; s0 = *(const f32x4*)sp; s1 = *(const f32x4*)(sp + 4); }
                    else { const u32x4 sw = *(const u32x4*)((const bf16_t*)src + off + bj * HALF);
                        s0 = f32x4{__builtin_bit_cast(float, sw.x << 16), __builtin_bit_cast(float, sw.x & 0xffff0000u), __builtin_bit_cast(float, sw.y << 16), __builtin_bit_cast(float, sw.y & 0xffff0000u)};
                        s1 = f32x4{__builtin_bit_cast(float, sw.z << 16), __builtin_bit_cast(float, sw.z & 0xffff0000u), __builtin_bit_cast(float, sw.w << 16), __builtin_bit_cast(float, sw.w & 0xffff0000u)}; }
                    const f32x4 o0 = s0 + acc[ai][bj][m][0], o1 = s1 + acc[ai][bj][m][1];
                    u32x4 w; w.x = cvt_pk_bf16(o0[0], o0[1]); w.y = cvt_pk_bf16(o0[2], o0[3]); w.z = cvt_pk_bf16(o1[0], o1[1]); w.w = cvt_pk_bf16(o1[2], o1[3]);
                    *(u32x4*)(dst + off + bj * HALF) = w;
                    ss += ((o0[0] * o0[0] + o0[1] * o0[1]) + (o0[2] * o0[2] + o0[3] * o0[3])) + ((o1[0] * o1[0] + o1[1] * o1[1]) + (o1[2] * o1[2] + o1[3] * o1[3]));
                    if (F8OUT) { typedef unsigned u32x2 __attribute__((ext_vector_type(2))); u32x2 w8; w8.x = pk4_fp8(o0[0], o0[1], o0[2], o0[3]); w8.y = pk4_fp8(o1[0], o1[1], o1[2], o1[3]);
                        *(u32x2*)(XN8 + off + bj * HALF) = w8; } }
                ss += __shfl_xor(ss, 16); ss += __shfl_xor(ss, 32);
                if (fq == 0) SS[(size_t)row * 64 + u.pn * 4 + wc] = ss; }
    }
};
template <int ACT> struct EpiAct {
    static constexpr bool PERM = true, AFTER_DRAIN = false, IDEMPOTENT = true;
    bf16_t* O; int ldc; const PG8_LAS float* lr;
    __device__ __forceinline__ void operator()(const f32x4 (&acc)[2][2][4][2], const Unit& u, int wr, int wc, int fr, int fq) const {
        const int row0 = u.pm * BM + wr * 64 + fr, col0 = u.pn * BM + wc * 32 + 8 * fq;
        float rs[2][4];
        if (ACT == 2) {
#pragma unroll
            for (int ai = 0; ai < 2; ++ai)
#pragma unroll
                for (int m = 0; m < 4; ++m) rs[ai][m] = lr[u.idx * 256 + wr * 64 + fr + ai * HALF + m * 16]; }
#pragma unroll
        for (int ai = 0; ai < 2; ++ai)
#pragma unroll
            for (int m = 0; m < 4; ++m) { bf16_t* rowp = O + (size_t)(row0 + ai * HALF + m * 16) * ldc + col0;
#pragma unroll
                for (int bj = 0; bj < 2; ++bj) { f32x4 v0 = acc[ai][bj][m][0], v1 = acc[ai][bj][m][1];
                    if (ACT == 2) { const f32x4 z = {0.f, 0.f, 0.f, 0.f}; v0 = __builtin_elementwise_max(v0, z) * rs[ai][m]; v1 = __builtin_elementwise_max(v1, z) * rs[ai][m]; v0 = v0 * v0; v1 = v1 * v1; }
                    u32x4 w; w.x = cvt_pk_bf16(v0[0], v0[1]); w.y = cvt_pk_bf16(v0[2], v0[3]); w.z = cvt_pk_bf16(v1[0], v1[1]); w.w = cvt_pk_bf16(v1[2], v1[3]);
                    *(u32x4*)(rowp + bj * HALF) = w; } }
    }
};
template <bool NEXT> struct EpiPle {
    static constexpr bool PERM = true, AFTER_DRAIN = false, IDEMPOTENT = false;
    bf16_t* H; const bf16_t* PP; int ldc; const PG8_LAS float* lr; float* SSout; unsigned char* XN8;
    __device__ __forceinline__ void operator()(const f32x4 (&acc)[2][2][4][2], const Unit& u, int wr, int wc, int fr, int fq) const {
        const int row0 = u.pm * BM + wr * 64 + fr, col0 = u.pn * BM + wc * 32 + 8 * fq;
        float rs[2][4];
#pragma unroll
        for (int ai = 0; ai < 2; ++ai)
#pragma unroll
            for (int m = 0; m < 4; ++m) rs[ai][m] = lr[u.idx * 256 + wr * 64 + fr + ai * HALF + m * 16];
#pragma unroll
        for (int ai = 0; ai < 2; ++ai)
#pragma unroll
            for (int m = 0; m < 4; ++m) { const int row = row0 + ai * HALF + m * 16; const size_t off = (size_t)row * ldc + col0; float ss = 0.f;
#pragma unroll
                for (int bj = 0; bj < 2; ++bj) { const f32x4 v0 = acc[ai][bj][m][0] * rs[ai][m], v1 = acc[ai][bj][m][1] * rs[ai][m];
                    const u32x4 pw = *(const u32x4*)(PP + off + bj * HALF); const u32x4 hw = *(const u32x4*)(H + off + bj * HALF);
                    f32x4 p0 = {__builtin_bit_cast(float, pw.x << 16), __builtin_bit_cast(float, pw.x & 0xffff0000u), __builtin_bit_cast(float, pw.y << 16), __builtin_bit_cast(float, pw.y & 0xffff0000u)};
                    f32x4 p1 = {__builtin_bit_cast(float, pw.z << 16), __builtin_bit_cast(float, pw.z & 0xffff0000u), __builtin_bit_cast(float, pw.w << 16), __builtin_bit_cast(float, pw.w & 0xffff0000u)};
                    f32x4 h0 = {__builtin_bit_cast(float, hw.x << 16), __builtin_bit_cast(float, hw.x & 0xffff0000u), __builtin_bit_cast(float, hw.y << 16), __builtin_bit_cast(float, hw.y & 0xffff0000u)};
                    f32x4 h1 = {__builtin_bit_cast(float, hw.z << 16), __builtin_bit_cast(float, hw.z & 0xffff0000u), __builtin_bit_cast(float, hw.w << 16), __builtin_bit_cast(float, hw.w & 0xffff0000u)};
#pragma unroll
                    for (int i = 0; i < 4; ++i) { h0[i] += p0[i] * __builtin_amdgcn_rcpf(1.0f + __expf(-v0[i])); h1[i] += p1[i] * __builtin_amdgcn_rcpf(1.0f + __expf(-v1[i])); }
                    u32x4 w; w.x = cvt_pk_bf16(h0[0], h0[1]); w.y = cvt_pk_bf16(h0[2], h0[3]); w.z = cvt_pk_bf16(h1[0], h1[1]); w.w = cvt_pk_bf16(h1[2], h1[3]);
                    *(u32x4*)(H + off + bj * HALF) = w;
                    if (NEXT) { ss += ((h0[0] * h0[0] + h0[1] * h0[1]) + (h0[2] * h0[2] + h0[3] * h0[3])) + ((h1[0] * h1[0] + h1[1] * h1[1]) + (h1[2] * h1[2] + h1[3] * h1[3]));
                        typedef unsigned u32x2 __attribute__((ext_vector_type(2))); u32x2 w8; w8.x = pk4_fp8(h0[0], h0[1], h0[2], h0[3]); w8.y = pk4_fp8(h1[0], h1[1], h1[2], h1[3]); *(u32x2*)(XN8 + off + bj * HALF) = w8; } }
                if (NEXT) { ss += __shfl_xor(ss, 16); ss += __shfl_xor(ss, 32); if (fq == 0) SSout[(size_t)row * 64 + u.pn * 4 + wc] = ss; } }
    }
};
}

constexpr int PH_PER_LAYER = 7, NPH = 2 + 2 * PH_PER_LAYER;

constexpr int LRSTD_OFF = LDSCTL_OFF + 2048;
template <class Sched>
__device__ __forceinline__ void rstd_prepass(LAS unsigned char* lds, const Sched& S, const float* SS) {
    int tid_ = threadIdx.x; asm volatile("" : "+v"(tid_));
    const int tid = tid_, r = tid >> 1, half = tid & 1;
    LAS float* lr = (LAS float*)(lds + LRSTD_OFF);
    pg8::Unit u;
    for (int i = 0; i < 8 && S.next(i, u); ++i) {
        const f32x4* sp = (const f32x4*)(SS + (size_t)(u.pm * 256 + r) * 64 + 32 * half);
        f32x4 v[8];
#pragma unroll
        for (int k = 0; k < 8; ++k) v[k] = sp[k];
        float s = 0.f;
#pragma unroll
        for (int k = 0; k < 8; ++k) s += (v[k][0] + v[k][1]) + (v[k][2] + v[k][3]);
        s += __shfl_xor(s, 1);
        if (half == 0) lr[i * 256 + r] = 1.0f / sqrtf(s * (1.0f / 4096.0f) + 1e-6f);
    }
    __syncthreads();
}
struct Params { const void* in[20]; float* out; unsigned char* ws; int ph_lo, ph_hi; };
enum { I_X = 0, I_P, I_POS, I_NATT, I_WIN, I_FOXB, I_PEK, I_W1K, I_W2K, I_PEV, I_W1V, I_W2V, I_WO, I_NMLP, I_WUP, I_WDN, I_NPLE, I_WG, I_WPP, I_NFIN };

template <bool F32OUT, bool SRC16 = false>
__device__ __forceinline__ void norm_phase(const float* src, const float* g, void* dst, int gw, int NGW, int lane, unsigned char* dst8 = nullptr) {
    for (int row = gw; row < MROWS; row += NGW) {
        const f32x4* xr = (const f32x4*)(src + (size_t)row * DM) + lane;
        f32x4 v[16]; float ss = 0.f;
#pragma unroll
        for (int j = 0; j < 16; ++j) { if (SRC16) { const v2u hw = *((const v2u*)((const bf16*)src + (size_t)row * DM) + lane + 64 * j); v[j] = f32x4{bflo(hw.x), bfhi(hw.x), bflo(hw.y), bfhi(hw.y)}; } else v[j] = xr[64 * j]; ss += (v[j][0] * v[j][0] + v[j][1] * v[j][1]) + (v[j][2] * v[j][2] + v[j][3] * v[j][3]); }
        const float rstd = 1.0f / sqrtf(wave_sum(ss) * (1.0f / DM) + RMS_EPS);
#pragma unroll
        for (int j = 0; j < 16; ++j) { const f32x4 one = {1.f, 1.f, 1.f, 1.f}; const f32x4 gg = g ? *((const f32x4*)g + lane + 64 * j) : one; const f32x4 o = v[j] * rstd * gg;
            if (F32OUT) *((f32x4*)((float*)dst + (size_t)row * DM) + lane + 64 * j) = o;
            else { v2u w; w.x = pk2(o[0], o[1]); w.y = pk2(o[2], o[3]); *((v2u*)((bf16*)dst + (size_t)row * DM) + lane + 64 * j) = w;
                if (dst8) *((unsigned*)(dst8 + (size_t)row * DM) + lane + 64 * j) = pk4_fp8(o[0], o[1], o[2], o[3]); } }
    }
}

__device__ __forceinline__ int win_rowmap(int n) {
    int c;
    if (n < 2560) c = n; else if (n < 2584) c = 11776 + (n - 2560); else if (n < 5656) c = n - 24; else if (n < 5664) c = 11776 + 24 + (n - 5656); else c = n - 32;
    if (c < 11776) { const int hb = c >> 7; if (hb_is_rope(hb)) { const int d = c & 127, e = d & 63, nn = d >> 6; c = (hb << 7) + 32 * (e >> 4) + 8 * ((e >> 2) & 3) + 4 * nn + (e & 3); } }
    return c;
}
template <bool WINMAP, bool F8 = false, bool WOSPLIT = false>
__device__ __forceinline__ void p0_transpose_item(const float* W, int K, int N, bf16* WT, LAS float* scr, int item, int lane, const float* gk = nullptr) {
    const int nblk = N / 32, kb = item / nblk, nb = item % nblk, k0 = 64 * kb, n0 = 32 * nb;
#pragma unroll 8
    for (int i = 0; i < 32; ++i) { const int kk = 2 * i + (lane >> 5); scr[kk * 33 + (lane & 31)] = __builtin_nontemporal_load(W + (size_t)(k0 + kk) * N + n0 + (lane & 31)); }
    LDS_WAIT(); asm volatile("" ::: "memory");
    const int c = lane & 7;
    f32x4 ga = {1.f, 1.f, 1.f, 1.f}, gb = ga;
    if (gk) { ga = *(const f32x4*)(gk + k0 + 8 * c); gb = *(const f32x4*)(gk + k0 + 8 * c + 4); }
#pragma unroll
    for (int j = 0; j < 4; ++j) { const int n = (lane >> 3) + 8 * j; const LAS float* s = scr + (8 * c) * 33 + n;
        const float e0 = s[0 * 33] * ga[0], e1 = s[1 * 33] * ga[1], e2 = s[2 * 33] * ga[2], e3 = s[3 * 33] * ga[3], e4 = s[4 * 33] * gb[0], e5 = s[5 * 33] * gb[1], e6 = s[6 * 33] * gb[2], e7 = s[7 * 33] * gb[3];
        v4u o; o.x = pk2(e0, e1); o.y = pk2(e2, e3); o.z = pk2(e4, e5); o.w = pk2(e6, e7);
        const int nr = WINMAP ? win_rowmap(n0 + n) : (n0 + n);
        if (WINMAP) { const unsigned code = PTYPE[nr >> 8]; const size_t rr = (size_t)(((code & 127u) << 8) + (nr & 255));
            if (code & 128u) { v2u o8; o8.x = pk4_fp8(e0 * 64.f, e1 * 64.f, e2 * 64.f, e3 * 64.f); o8.y = pk4_fp8(e4 * 64.f, e5 * 64.f, e6 * 64.f, e7 * 64.f);
                __builtin_nontemporal_store(o8, (GAS v2u*)((unsigned char*)WT + W_IN8 + rr * K + k0 + 8 * c)); }
            else __builtin_nontemporal_store(o, (GAS v4u*)(WT + rr * K + k0 + 8 * c)); }
        else if (WOSPLIT) { const int seg_ = k0 >> 10, kk0_ = (k0 & 1023) + (seg_ >= 2 ? 1024 : 0);
            if ((seg_ & 1) == 0) { v2u o8; o8.x = pk4_fp8(e0 * 64.f, e1 * 64.f, e2 * 64.f, e3 * 64.f); o8.y = pk4_fp8(e4 * 64.f, e5 * 64.f, e6 * 64.f, e7 * 64.f);
                __builtin_nontemporal_store(o8, (GAS v2u*)((unsigned char*)WT + (size_t)nr * MIXLD + MIXO8 + kk0_ + 8 * c)); }
            else __builtin_nontemporal_store(o, (GAS v4u*)(WT + (size_t)nr * (MIXLD / 2) + kk0_ + 8 * c)); }
        else if (F8) { v2u o8; o8.x = pk4_fp8(e0 * 64.f, e1 * 64.f, e2 * 64.f, e3 * 64.f); o8.y = pk4_fp8(e4 * 64.f, e5 * 64.f, e6 * 64.f, e7 * 64.f);
            __builtin_nontemporal_store(o8, (GAS v2u*)((unsigned char*)WT + (size_t)nr * K + k0 + 8 * c)); }
        else __builtin_nontemporal_store(o, (GAS v4u*)(WT + (size_t)nr * K + k0 + 8 * c)); }
    LDS_WAIT(); asm volatile("" ::: "memory");
}

__device__ __forceinline__ void prologue_phase(const Params& P, LAS unsigned char* lds, int gw, int NGW, int wave, int lane, int rep = 0) {
    LAS float* scr = (LAS float*)(lds + RING_OFF + wave * 16384);
    unsigned char* ws = P.ws;
    constexpr int I_IN = (DM / 64) * (NIN / 32), I_O = (DM / 64) * (DM / 32), I_UP = (DM / 64) * (DFF / 32), I_DN = (DFF / 64) * (DM / 32), I_G = I_O, I_PPJ = (PLE / 64) * (DM / 32), I_C1 = (4096 / 64) * (256 / 32), I_C2 = (256 / 64) * (128 / 32);
    constexpr int PER_LAYER = I_IN + I_O + I_UP + I_DN + I_G + I_PPJ + 2 * I_C1 + 2 * I_C2;
    for (int it = gw; it < 2 * PER_LAYER; it += NGW) {
        const int l = it >= PER_LAYER ? 1 : 0; int r = it - l * PER_LAYER;
        unsigned char* wl = ws + WS_W + (size_t)l * LAYER_W;
        if (r < I_IN) { p0_transpose_item<true>((const float*)P.in[I_WIN] + (size_t)l * DM * NIN, DM, NIN, (bf16*)(wl + W_IN), scr, r, lane, (const float*)P.in[I_NATT] + (size_t)l * DM); continue; } r -= I_IN;
        if (r < I_O) { p0_transpose_item<false, false, true>((const float*)P.in[I_WO] + (size_t)l * DM * DM, DM, DM, (bf16*)(wl + W_O), scr, r, lane); continue; } r -= I_O;
        if (r < I_UP) { p0_transpose_item<false>((const float*)P.in[I_WUP] + (size_t)l * DM * DFF, DM, DFF, (bf16*)(wl + W_UP), scr, r, lane, (const float*)P.in[I_NMLP] + (size_t)l * DM); continue; } r -= I_UP;
        if (r < I_DN) { p0_transpose_item<false>((const float*)P.in[I_WDN] + (size_t)l * DFF * DM, DFF, DM, (bf16*)(wl + W_DN), scr, r, lane); continue; } r -= I_DN;
        if (r < I_G) { p0_transpose_item<false, true>((const float*)P.in[I_WG] + (size_t)l * DM * DM, DM, DM, (bf16*)(wl + W_G), scr, r, lane, (const float*)P.in[I_NPLE] + (size_t)l * DM); continue; } r -= I_G;
        if (r < I_PPJ) { p0_transpose_item<false>((const float*)P.in[I_WPP] + (size_t)l * PLE * DM, PLE, DM, (bf16*)(wl + W_PP), scr, r, lane); continue; } r -= I_PPJ;
        if (r < I_C1) { p0_transpose_item<false>((const float*)P.in[I_W1K] + (size_t)l * 4096 * 256, 4096, 256, (bf16*)(wl + W_C1K), scr, r, lane); continue; } r -= I_C1;
        if (r < I_C1) { p0_transpose_item<false>((const float*)P.in[I_W1V] + (size_t)l * 4096 * 256, 4096, 256, (bf16*)(wl + W_C1V), scr, r, lane); continue; } r -= I_C1;
        if (r < I_C2) { p0_transpose_item<false>((const float*)P.in[I_W2K] + (size_t)l * 256 * 128, 256, 128, (bf16*)(wl + W_C2K), scr, r, lane); continue; } r -= I_C2;
        p0_transpose_item<false>((const float*)P.in[I_W2V] + (size_t)l * 256 * 128, 256, 128, (bf16*)(wl + W_C2V), scr, r, lane);
    }
    if (gw < 256) {
        const int lkv = gw >> 6, kc = gw & 63, l = lkv >> 1, kv = lkv & 1;
        const float* pe = (const float*)P.in[kv ? I_PEV : I_PEK] + (size_t)l * 4096; const float* w1 = (const float*)P.in[kv ? I_W1V : I_W1K] + (size_t)l * 4096 * 256;
        f32x4 acc = {0.f, 0.f, 0.f, 0.f};
#pragma unroll 8
        for (int kk = 0; kk < 64; ++kk) { const int k = 64 * kc + kk; acc += pe[k] * *(const f32x4*)(w1 + (size_t)k * 256 + 4 * lane); }
        *(f32x4*)((float*)(ws + WS_CBP) + (size_t)(lkv * 64 + kc) * 256 + 4 * lane) = acc;
    }
    { const float* p = (const float*)P.in[I_P]; bf16* pb = (bf16*)(ws + WS_PB); const int n4 = DEPTH * MROWS * PLE / 4;
      for (int i = gw * 64 + lane; i < n4; i += NGW * 64) { const f32x4 v = *(const f32x4*)(p + (size_t)i * 4); v2u o; o.x = pk2(v[0], v[1]); o.y = pk2(v[2], v[3]); *(v2u*)(pb + (size_t)i * 4) = o; } }
    norm_phase<false>((const float*)P.in[I_X], nullptr, (bf16*)(ws + WS_XN), gw, NGW, lane, ws + WS_XN8);
    { const int* pos = (const int*)P.in[I_POS]; float* cs = (float*)(ws + WS_ROPE);
      for (int i = gw * 64 + lane; i < MROWS * 64; i += NGW * 64) { const int row = i >> 6, e = i & 63;
          const double inv = exp(-9.210340371976184 * (double)e / 64.0), a = (double)pos[row] * inv; double sn, cn; sincos(a, &sn, &cn);
          cs[i] = (float)cn; cs[(size_t)MROWS * 64 + i] = (float)sn; } }
}

__device__ __forceinline__ float gelu_tanh(float x) { const float u = 0.7978845608028654f * (x + 0.044715f * x * x * x); return 0.5f * x * (1.0f + tanhf(u)); }
__device__ __forceinline__ float log_sigmoid_f(float x) { return fminf(x, 0.f) - log1pf(expf(-fabsf(x))); }

__device__ __forceinline__ const bf16* head_ptr(const bf16* QKV, int hb, int b) { return QKV + (size_t)(hb * NB + b) * SEQ * HD; }
namespace fa {
typedef short bf16x8 __attribute__((ext_vector_type(8)));
typedef short s16x4 __attribute__((ext_vector_type(4)));
typedef float f32x16 __attribute__((ext_vector_type(16)));
typedef unsigned u32x4 __attribute__((ext_vector_type(4)));
constexpr int KVBLK = 64, SHM = 16384;
constexpr int L_V = 0, L_K = 2 * SHM, L_BIAS = 4 * SHM, L_WS = L_BIAS + 512, L_MISC = L_WS + 8 * 256, L_END = L_MISC + 256;
constexpr float SCALE = 0.08838834764831845f, C2 = 1.4426950408889634f * SCALE, THR = 8.f;
#define FA_KSWZ(row, colB) ((row) * 256 + ((colB) ^ (((row) & 7) << 4)))
#define FA_SBAR() __builtin_amdgcn_sched_barrier(0)
__device__ __forceinline__ int v_st(int k, int c) { const int kk = (k & ~0xC) | ((k & 4) << 1) | ((k & 8) >> 1); return ((kk >> 3) * 4 + (c >> 5)) * 512 + ((kk & 7) * 32 + (c & 31)) * 2; }
__device__ __forceinline__ int v_rd_base(int lane) { return ((lane & 3) << 3) | (((lane >> 2) & 3) << 6) | (((lane >> 4) & 1) << 5) | (((lane >> 5) & 1) << 8); }
constexpr int v_rd_off(int d0, int ks, int half) { return d0 * 512 + ks * 4096 + half * 2048; }
__device__ __forceinline__ int crow(int r, int hi) { return (r & 3) + 8 * (r >> 2) + 4 * hi; }
__device__ __forceinline__ unsigned cvtpk(float lo, float hi) { unsigned r; asm volatile("v_cvt_pk_bf16_f32 %0, %1, %2" : "=v"(r) : "v"(lo), "v"(hi)); return r; }

__device__ __forceinline__ void mask_tile(f32x16& p0, f32x16& p1, int dq, unsigned W) {
    const float NEG = -__builtin_inff();
#pragma unroll
    for (int r = 0; r < 16; ++r) { const int c = (r & 3) + 8 * (r >> 2);
        if ((unsigned)(dq - c) >= W) p0[r] = NEG;
        if ((unsigned)(dq - c - 32) >= W) p1[r] = NEG; }
}
__device__ __forceinline__ void partialSM(f32x16& p0, f32x16& p1, float& m_reg, float& mn, float& alpha) {
    float pmax = p0[0];
#pragma unroll
    for (int r = 1; r < 16; ++r) pmax = fmaxf(pmax, p0[r]);
#pragma unroll
    for (int r = 0; r < 16; ++r) pmax = fmaxf(pmax, p1[r]);
    { auto rr = __builtin_amdgcn_permlane32_swap(__float_as_uint(pmax), __float_as_uint(pmax), false, false);
      pmax = fmaxf(__uint_as_float(rr[0]), __uint_as_float(rr[1])); }
    if (__builtin_expect(__all((pmax - m_reg) * SCALE <= THR), 1)) { mn = m_reg; alpha = 1.f; }
    else { mn = fmaxf(m_reg, pmax); alpha = __builtin_amdgcn_exp2f((m_reg - mn) * C2); m_reg = mn; }
    const float mnL = -mn * C2;
#pragma unroll
    for (int r = 0; r < 16; ++r) p0[r] = __builtin_amdgcn_exp2f(fmaf(p0[r], C2, mnL));
#pragma unroll
    for (int r = 0; r < 16; ++r) p1[r] = __builtin_amdgcn_exp2f(fmaf(p1[r], C2, mnL));
}
#define FA_PK4(P, B_, OUT) do { unsigned a0 = cvtpk(P[B_+0], P[B_+1]), a1 = cvtpk(P[B_+2], P[B_+3]); unsigned b0 = cvtpk(P[B_+4], P[B_+5]), b1 = cvtpk(P[B_+6], P[B_+7]); \
        auto r0 = __builtin_amdgcn_permlane32_swap(a0, b0, false, false); auto r1 = __builtin_amdgcn_permlane32_swap(a1, b1, false, false); \
        u32x4 w = {r0[0], r1[0], r0[1], r1[1]}; OUT = __builtin_bit_cast(bf16x8, w); } while (0)
__device__ __forceinline__ void finishSM(f32x16& p0, f32x16& p1, float alpha, float& l_reg, bf16x8& pa0, bf16x8& pa1, bf16x8& pa2, bf16x8& pa3) {
    float ps = 0;
#pragma unroll
    for (int r = 0; r < 16; ++r) ps += p0[r];
#pragma unroll
    for (int r = 0; r < 16; ++r) ps += p1[r];
    { auto rr = __builtin_amdgcn_permlane32_swap(__float_as_uint(ps), __float_as_uint(ps), false, false); ps = __uint_as_float(rr[0]) + __uint_as_float(rr[1]); }
    l_reg = l_reg * alpha + ps;
    FA_PK4(p0, 0, pa0); FA_PK4(p0, 8, pa1); FA_PK4(p1, 0, pa2); FA_PK4(p1, 8, pa3);
}
template <int KB>
__device__ __forceinline__ void qkt(f32x16& p0, f32x16& p1, const LAS char* lds, int r32, int hi, const bf16x8* qr) {
    p0 = f32x16{}; p1 = f32x16{};
    const LAS char* kb[4];
#pragma unroll
    for (int dd = 0; dd < 4; ++dd) kb[dd] = lds + L_K + KB * SHM + FA_KSWZ(r32, (dd * 16 + hi * 8) * 2);
#pragma unroll
    for (int d0 = 0; d0 < 8; ++d0) { const LAS char* a = kb[d0 & 3] + (d0 >> 2) * 128;
        const bf16x8 b0 = *(const LAS bf16x8*)a, b1 = *(const LAS bf16x8*)(a + 32 * 256);
        p0 = __builtin_amdgcn_mfma_f32_32x32x16_bf16(b0, qr[d0], p0, 0, 0, 0);
        p1 = __builtin_amdgcn_mfma_f32_32x32x16_bf16(b1, qr[d0], p1, 0, 0, 0); }
}
template <int VB>
__device__ __forceinline__ void pv_tile(f32x16* o, int vb0, bf16x8 pa0, bf16x8 pa1, bf16x8 pa2, bf16x8 pa3) {
#define FA_TRRD(dst, off) asm volatile("ds_read_b64_tr_b16 %0, %1 offset:%2" : "=&v"(dst) : "v"(vb0), "i"(off) : "memory")
#define FA_PV_D0(d0) do { s16x4 l0, l1, l2, l3, h0, h1, h2, h3; constexpr int b_ = L_V + VB * SHM + v_rd_off(d0, 0, 0); \
        FA_TRRD(l0, b_); FA_TRRD(h0, b_ + 2048); FA_TRRD(l1, b_ + 4096); FA_TRRD(h1, b_ + 6144); FA_TRRD(l2, b_ + 8192); FA_TRRD(h2, b_ + 10240); FA_TRRD(l3, b_ + 12288); FA_TRRD(h3, b_ + 14336); \
        asm volatile("s_waitcnt lgkmcnt(0)" ::: "memory"); FA_SBAR(); \
        o[d0] = __builtin_amdgcn_mfma_f32_32x32x16_bf16(pa0, (bf16x8){l0[0], l0[1], l0[2], l0[3], h0[0], h0[1], h0[2], h0[3]}, o[d0], 0, 0, 0); \
        o[d0] = __builtin_amdgcn_mfma_f32_32x32x16_bf16(pa1, (bf16x8){l1[0], l1[1], l1[2], l1[3], h1[0], h1[1], h1[2], h1[3]}, o[d0], 0, 0, 0); \
        o[d0] = __builtin_amdgcn_mfma_f32_32x32x16_bf16(pa2, (bf16x8){l2[0], l2[1], l2[2], l2[3], h2[0], h2[1], h2[2], h2[3]}, o[d0], 0, 0, 0); \
        o[d0] = __builtin_amdgcn_mfma_f32_32x32x16_bf16(pa3, (bf16x8){l3[0], l3[1], l3[2], l3[3], h3[0], h3[1], h3[2], h3[3]}, o[d0], 0, 0, 0); } while (0)
    FA_PV_D0(0); FA_PV_D0(1); FA_PV_D0(2); FA_PV_D0(3);
#undef FA_PV_D0
#undef FA_TRRD
}

struct Blk {
    const bf16* Q; int qstride;
    const bf16* K; const bf16* V; int kvstride;
    int qpos;
    int j_lo, j_hi;
};
struct Extra { const float* cum; float cref; unsigned mlo, mhi; int W; };

struct Stage { bf16x8 k0, k1, v0, v1; f32x4 cb; };
template <int MODE>
__device__ __forceinline__ void stage_load(Stage& S, const Blk& B, const Extra& X, int j, int sr, int sc, int tid) {
    const size_t r0 = (size_t)(j * KVBLK + sr) * B.kvstride + sc, r1 = r0 + (size_t)32 * B.kvstride;
    S.v0 = *(const bf16x8*)(B.V + r0); S.v1 = *(const bf16x8*)(B.V + r1);
    S.k0 = *(const bf16x8*)(B.K + r0); S.k1 = *(const bf16x8*)(B.K + r1);
    if (MODE == 0) { if (tid < 16) S.cb = *(const f32x4*)(X.cum + j * KVBLK + tid * 4); }
}
template <int MODE>
__device__ __forceinline__ void stage_write(const Stage& S, LAS char* lds, int buf, int kws, int vst0, int vst1, float cref, int tid) {
    *(LAS bf16x8*)(lds + L_V + buf * SHM + vst0) = S.v0; *(LAS bf16x8*)(lds + L_V + buf * SHM + vst1) = S.v1;
    *(LAS bf16x8*)(lds + L_K + buf * SHM + kws) = S.k0; *(LAS bf16x8*)(lds + L_K + buf * SHM + kws + 32 * 256) = S.k1;
    if (MODE == 0) { if (tid < 16) { const float is = 11.313708498984761f; f32x4 b = {(cref - S.cb[0]) * is, (cref - S.cb[1]) * is, (cref - S.cb[2]) * is, (cref - S.cb[3]) * is};
        *(LAS f32x4*)(lds + L_BIAS + buf * 256 + tid * 16) = b; } }
}

template <int MODE>
__device__ __forceinline__ void softmax_block(LAS char* lds, const Blk& B, const Extra& X, f32x16 (&o)[4], float& m_reg, float& l_reg) {
    int tid_ = threadIdx.x; asm volatile("" : "+v"(tid_));
    const int tid = tid_, wid = __builtin_amdgcn_readfirstlane(tid >> 6), lane = tid & 63, r32 = lane & 31, hi = lane >> 5;
    const int sr = tid >> 4, sc = (tid & 15) * 8, kws = FA_KSWZ(sr, sc * 2), vst0 = v_st(sr, sc), vst1 = v_st(32 + sr, sc);
    const int vb0 = (int)(unsigned)(size_t)(lds) + v_rd_base(lane);
    LAS float* al_l = (LAS float*)(lds + L_WS + wid * 256);
    const int W = (MODE == 2) ? X.W : (1 << 30);
    const int qlo = B.qpos, qm = qlo + r32 - 4 * hi;
    bf16x8 qr[8];
#pragma unroll
    for (int d0 = 0; d0 < 8; ++d0) qr[d0] = *(const bf16x8*)(B.Q + (size_t)r32 * B.qstride + d0 * 16 + hi * 8);
#pragma unroll
    for (int d = 0; d < 4; ++d) o[d] = f32x16{};
    m_reg = -1e30f; l_reg = 0.f;
    const int NT = B.j_hi - B.j_lo;
    Stage S;
    stage_load<MODE>(S, B, X, B.j_lo, sr, sc, tid);
    asm volatile("s_waitcnt vmcnt(0)" ::: "memory");
    stage_write<MODE>(S, lds, 0, kws, vst0, vst1, X.cref, tid);
    __syncthreads();
    f32x16 p0, p1; float mn, alpha; bf16x8 pa0, pa1, pa2, pa3;
#define FA_STEP(t, BUF) do { const int j_ = B.j_lo + (t), kb_ = j_ * KVBLK; \
        if ((t) + 1 < NT) stage_load<MODE>(S, B, X, j_ + 1, sr, sc, tid); \
        const bool act_ = (kb_ <= qlo + 31) && (kb_ + KVBLK - 1 >= qlo - W + 1); \
        if (act_) { \
            FA_SBAR(); qkt<BUF>(p0, p1, lds, r32, hi, qr); \
            if (MODE == 0) { const LAS f32x4* bp = (const LAS f32x4*)(lds + L_BIAS + BUF * 256) + hi; \
                _Pragma("unroll") for (int g_ = 0; g_ < 4; ++g_) { const f32x4 b0 = bp[2 * g_], b1 = bp[8 + 2 * g_]; \
                    _Pragma("unroll") for (int i_ = 0; i_ < 4; ++i_) { p0[4 * g_ + i_] += b0[i_]; p1[4 * g_ + i_] += b1[i_]; } } } \
            if (MODE == 1) { const bool sel_ = ((j_ < 32 ? (X.mlo >> j_) : (X.mhi >> (j_ - 32))) & 1u) != 0u; \
                if (!sel_) { const float NEG_ = -__builtin_inff(); _Pragma("unroll") for (int r = 0; r < 16; ++r) { p0[r] = NEG_; p1[r] = NEG_; } } } \
            if (kb_ + KVBLK - 1 > qlo || kb_ <= qlo + 31 - W) mask_tile(p0, p1, qm - kb_, (unsigned)W); \
            partialSM(p0, p1, m_reg, mn, alpha); \
            if (__any(alpha < 1.f)) { if (hi == 0) al_l[r32] = alpha; asm volatile("s_waitcnt lgkmcnt(0)" ::: "memory"); \
                _Pragma("unroll") for (int r = 0; r < 16; ++r) { const float a_ = al_l[crow(r, hi)]; _Pragma("unroll") for (int d_ = 0; d_ < 4; ++d_) o[d_][r] *= a_; } } \
            finishSM(p0, p1, alpha, l_reg, pa0, pa1, pa2, pa3); FA_SBAR(); \
            pv_tile<BUF>(o, vb0, pa0, pa1, pa2, pa3); } \
        if ((t) + 1 < NT) { asm volatile("s_waitcnt vmcnt(0)" ::: "memory"); stage_write<MODE>(S, lds, (BUF) ^ 1, kws, vst0, vst1, X.cref, tid); } \
        __syncthreads(); } while (0)
    for (int t = 0; t < NT; t += 2) { FA_STEP(t, 0); if (t + 1 < NT) FA_STEP(t + 1, 1); }
#undef FA_STEP
}

__device__ __forceinline__ float swap32(float v, int hi) {
    auto rr = __builtin_amdgcn_permlane32_swap(__float_as_uint(v), __float_as_uint(v), false, false);
    return __uint_as_float(hi ? rr[0] : rr[1]);
}
__device__ __forceinline__ void sb_weights(f32x16& p0, f32x16& p1, float& carry, int dq, bool needmask, int hi) {
    f32x16 l0, l1;
#pragma unroll
    for (int r = 0; r < 16; ++r) { const int c = (r & 3) + 8 * (r >> 2);
        { const float z = p0[r] * C2; const float sp = fmaxf(z, 0.f) + __builtin_amdgcn_logf(1.f + __builtin_amdgcn_exp2f(-fabsf(z))); const bool v = !needmask || (dq - c > 0); p0[r] = v ? z : -__builtin_inff(); l0[r] = v ? -sp : 0.f; }
        { const float z = p1[r] * C2; const float sp = fmaxf(z, 0.f) + __builtin_amdgcn_logf(1.f + __builtin_amdgcn_exp2f(-fabsf(z))); const bool v = !needmask || (dq - c - 32 > 0); p1[r] = v ? z : -__builtin_inff(); l1[r] = v ? -sp : 0.f; } }
    float T[8];
#pragma unroll
    for (int g = 0; g < 4; ++g) { l0[4 * g + 2] += l0[4 * g + 3]; l0[4 * g + 1] += l0[4 * g + 2]; l0[4 * g] += l0[4 * g + 1]; T[g] = l0[4 * g];
                                  l1[4 * g + 2] += l1[4 * g + 3]; l1[4 * g + 1] += l1[4 * g + 2]; l1[4 * g] += l1[4 * g + 1]; T[4 + g] = l1[4 * g]; }
    float ex[8], send[8]; float run = 0.f;
#pragma unroll
    for (int k = 7; k >= 0; --k) { ex[k] = run; run += T[k]; send[k] = hi ? run : ex[k]; }
    const float tot_all = run + swap32(run, hi);
#pragma unroll
    for (int k = 0; k < 8; ++k) { const float off = ex[k] + swap32(send[k], hi) + carry;
#pragma unroll
        for (int i = 0; i < 4; ++i) { if (k < 4) l0[4 * k + i] += off; else l1[4 * (k - 4) + i] += off; } }
#pragma unroll
    for (int r = 0; r < 16; ++r) { p0[r] = __builtin_amdgcn_exp2f(p0[r] + l0[r]); p1[r] = __builtin_amdgcn_exp2f(p1[r] + l1[r]); }
    carry += tot_all;
}
__device__ __forceinline__ void sb_block(LAS char* lds, const Blk& B, f32x16 (&o)[4]) {
    int tid_ = threadIdx.x; asm volatile("" : "+v"(tid_));
    const int tid = tid_, wid = __builtin_amdgcn_readfirstlane(tid >> 6), lane = tid & 63, r32 = lane & 31, hi = lane >> 5;
    const int sr = tid >> 4, sc = (tid & 15) * 8, kws = FA_KSWZ(sr, sc * 2), vst0 = v_st(sr, sc), vst1 = v_st(32 + sr, sc);
    const int vb0 = (int)(unsigned)(size_t)(lds) + v_rd_base(lane);
    volatile LAS unsigned* dflag = (volatile LAS unsigned*)(lds + L_MISC + 64);
    const int qlo = B.qpos, qm = qlo + r32 - 4 * hi;
    bf16x8 qr[8];
#pragma unroll
    for (int d0 = 0; d0 < 8; ++d0) qr[d0] = *(const bf16x8*)(B.Q + (size_t)r32 * B.qstride + d0 * 16 + hi * 8);
#pragma unroll
    for (int d = 0; d < 4; ++d) o[d] = f32x16{};
    float carry = 0.f; bool wdone = false;
    const int NT = B.j_hi - B.j_lo;
    Stage S; Extra X{};
    if (lane == 0) { dflag[wid] = 0u; dflag[8 + wid] = 0u; }
    stage_load<3>(S, B, X, B.j_hi - 1, sr, sc, tid);
    asm volatile("s_waitcnt vmcnt(0)" ::: "memory");
    stage_write<3>(S, lds, 0, kws, vst0, vst1, 0.f, tid);
    __syncthreads();
    f32x16 p0, p1; bf16x8 pa0, pa1, pa2, pa3;
#define FA_SBSTEP(t, BUF) do { const int j_ = B.j_hi - 1 - (t), kb_ = j_ * KVBLK; \
        if ((t) + 1 < NT) stage_load<3>(S, B, X, j_ - 1, sr, sc, tid); \
        const bool act_ = !wdone && (kb_ < qlo + 31); \
        if (act_) { \
            FA_SBAR(); qkt<BUF>(p0, p1, lds, r32, hi, qr); \
            sb_weights(p0, p1, carry, qm - kb_, kb_ + KVBLK - 1 >= qlo, hi); \
            FA_PK4(p0, 0, pa0); FA_PK4(p0, 8, pa1); FA_PK4(p1, 0, pa2); FA_PK4(p1, 8, pa3); FA_SBAR(); \
            pv_tile<BUF>(o, vb0, pa0, pa1, pa2, pa3); \
            wdone = __all(carry < -160.f); } \
        if (lane == 0) dflag[((t) & 1) * 8 + wid] = (wdone || kb_ == 0) ? 1u : 0u; \
        if ((t) + 1 < NT) { asm volatile("s_waitcnt vmcnt(0)" ::: "memory"); stage_write<3>(S, lds, (BUF) ^ 1, kws, vst0, vst1, 0.f, tid); } \
        __syncthreads(); \
        { unsigned all_ = 1u; _Pragma("unroll") for (int w_ = 0; w_ < 8; ++w_) all_ &= dflag[((t) & 1) * 8 + w_]; stop = all_ != 0u; } } while (0)
    bool stop = false;
    for (int t = 0; t < NT; t += 2) { FA_SBSTEP(t, 0); if (stop) break; if (t + 1 < NT) { FA_SBSTEP(t + 1, 1); if (stop) break; } }
#undef FA_SBSTEP
    __syncthreads();
}

__device__ __forceinline__ void row_scales(LAS char* lds, int wid, int r32, int hi, float rs, float (&sc)[16]) {
    LAS float* li_l = (LAS float*)(lds + L_WS + wid * 256) + 32;
    if (hi == 0) li_l[r32] = rs;
    asm volatile("s_waitcnt lgkmcnt(0)" ::: "memory");
#pragma unroll
    for (int r = 0; r < 16; ++r) sc[r] = li_l[crow(r, hi)];
    asm volatile("s_waitcnt lgkmcnt(0)" ::: "memory");
}
__device__ __forceinline__ void store_bf16(const f32x16 (&o)[4], const float (&sc)[16], bf16* dst, size_t ld, int r32, int hi) {
#pragma unroll
    for (int r = 0; r < 16; ++r) { const int orow = crow(r, hi);
#pragma unroll
        for (int d0 = 0; d0 < 4; ++d0) { const float v = o[d0][r] * sc[r]; const float vn = __shfl_xor(v, 1);
            if ((r32 & 1) == 0) *(unsigned*)(dst + (size_t)orow * ld + d0 * 32 + r32) = cvtpk(v, vn); } }
}
}

__device__ __forceinline__ void nsa_block(const Params& P, LAS char* lds, int b, int g, int qb) {
    unsigned char* ws = P.ws;
    const bf16* QKV = (const bf16*)(ws + WS_QKV);
    const float* GATE = (const float*)(ws + WS_GATE);
    int tid_ = threadIdx.x; asm volatile("" : "+v"(tid_));
    const int tid = tid_, wid = __builtin_amdgcn_readfirstlane(tid >> 6), lane = tid & 63, r32 = lane & 31, hi = lane >> 5;
    const int hh = wid & 3, tb = wid >> 2, h = 4 * g + hh, P0 = 64 * qb + 32 * tb, row0 = b * SEQ + P0;
    fa::Blk B; B.Q = head_ptr(QKV, HB_QA + h, b) + (size_t)P0 * HD; B.qstride = HD; B.kvstride = HD; B.qpos = P0;
    fa::f32x16 o[4]; float m_reg, l_reg; float sc[16];
    const float* oc = (const float*)(ws + WS_OCMP) + (size_t)row0 * 1024 + h * 128;
    float* os = (float*)(ws + WS_OS) + (size_t)row0 * 1024 + h * 128;
    {
        B.K = head_ptr(QKV, HB_KS + g, b); B.V = head_ptr(QKV, HB_VS + g, b); B.j_lo = 0; B.j_hi = qb + 1;
        const unsigned long long m = ((const unsigned long long*)(ws + WS_SEL))[(size_t)(b * 2 + g) * SEQ + P0 + r32];
        fa::Extra X{}; X.mlo = (unsigned)m; X.mhi = (unsigned)(m >> 32);
        fa::softmax_block<1>(lds, B, X, o, m_reg, l_reg);
        const float g1 = sigmoidf_(GATE[(size_t)(row0 + r32) * 32 + 3 * h + 1]);
        fa::row_scales(lds, wid, r32, hi, g1 / l_reg, sc);
#pragma unroll
        for (int r = 0; r < 16; ++r) { const int orow = fa::crow(r, hi);
#pragma unroll
            for (int d0 = 0; d0 < 4; ++d0) { const size_t off = (size_t)orow * 1024 + d0 * 32 + r32; os[off] = oc[off] + o[d0][r] * sc[r]; } }
    }
    {
        B.K = head_ptr(QKV, HB_KW + g, b); B.V = head_ptr(QKV, HB_VW + g, b); B.j_lo = qb >= 8 ? qb - 8 : 0; B.j_hi = qb + 1;
        fa::Extra X{}; X.W = 512;
        fa::softmax_block<2>(lds, B, X, o, m_reg, l_reg);
        const float g2 = sigmoidf_(GATE[(size_t)(row0 + r32) * 32 + 3 * h + 2]);
        fa::row_scales(lds, wid, r32, hi, g2 / l_reg, sc);
        asm volatile("s_waitcnt vmcnt(0)" ::: "memory"); __builtin_amdgcn_fence(__ATOMIC_ACQUIRE, "agent"); asm volatile("s_waitcnt vmcnt(0)" ::: "memory");
        unsigned char* mx = ws + WS_MIX + (size_t)row0 * MIXLD + MIXO8 + h * 128;
#pragma unroll
        for (int r = 0; r < 16; ++r) { const int orow = fa::crow(r, hi);
#pragma unroll
            for (int d0 = 0; d0 < 4; ++d0) { const float v = os[(size_t)orow * 1024 + d0 * 32 + r32] + o[d0][r] * sc[r]; const float vn = __shfl_xor(v, 1); const float v2 = __shfl_xor(v, 2), v3 = __shfl_xor(vn, 2);
                if ((r32 & 3) == 0) *(unsigned*)(mx + (size_t)orow * MIXLD + d0 * 32 + r32) = pk4_fp8(v, vn, v2, v3); } }
    }
}
__device__ __forceinline__ void fox_block(const Params& P, LAS char* lds, int b, int h, int x) {
    unsigned char* ws = P.ws;
    const bf16* QKV = (const bf16*)(ws + WS_QKV);
    int tid_ = threadIdx.x; asm volatile("" : "+v"(tid_));
    const int tid = tid_, wid = __builtin_amdgcn_readfirstlane(tid >> 6), lane = tid & 63, r32 = lane & 31, hi = lane >> 5;
    const int P0 = 256 * x + 32 * wid, row0 = b * SEQ + P0;
    fa::Blk B; B.Q = head_ptr(QKV, HB_QB + h, b) + (size_t)P0 * HD; B.qstride = HD; B.kvstride = HD; B.qpos = P0;
    B.K = head_ptr(QKV, HB_KB + h, b); B.V = head_ptr(QKV, HB_VB + h, b); B.j_lo = 0; B.j_hi = 4 * x + 4;
    fa::Extra X{}; X.cum = (const float*)(ws + WS_CUM) + (size_t)(b * 8 + h) * SEQ; X.cref = X.cum[256 * x];
    fa::f32x16 o[4]; float m_reg, l_reg; float sc[16];
    fa::softmax_block<0>(lds, B, X, o, m_reg, l_reg);
    fa::row_scales(lds, wid, r32, hi, 1.0f / l_reg, sc);
    fa::store_bf16(o, sc, (bf16*)(ws + WS_MIX) + (size_t)row0 * (MIXLD / 2) + h * 128, MIXLD / 2, r32, hi);
}
__device__ __forceinline__ void sbk_block(const Params& P, LAS char* lds, int b, int h, int x) {
    unsigned char* ws = P.ws;
    const bf16* QKV = (const bf16*)(ws + WS_QKV);
    int tid_ = threadIdx.x; asm volatile("" : "+v"(tid_));
    const int tid = tid_, wid = __builtin_amdgcn_readfirstlane(tid >> 6), lane = tid & 63, r32 = lane & 31, hi = lane >> 5;
    const int P0 = 256 * x + 32 * wid, row0 = b * SEQ + P0;
    fa::Blk B; B.Q = head_ptr(QKV, HB_QD + h, b) + (size_t)P0 * HD; B.qstride = HD; B.kvstride = HD; B.qpos = P0;
    B.K = head_ptr(QKV, HB_KD + h, b); B.V = head_ptr(QKV, HB_VD + h, b); B.j_lo = 0; B.j_hi = 4 * x + 4;
    fa::f32x16 o[4]; float sc[16];
    fa::sb_block(lds, B, o);
#pragma unroll
    for (int r = 0; r < 16; ++r) sc[r] = 1.f;
    fa::store_bf16(o, sc, (bf16*)(ws + WS_MIX) + (size_t)row0 * (MIXLD / 2) + 1024 + h * 128, MIXLD / 2, r32, hi);
}
constexpr int YQ_DIL = 3 * 16 * 16;
__device__ __forceinline__ void dil_block(const Params& P, LAS char* lds, int cfg, int b, int h, int blk) {
    unsigned char* ws = P.ws;
    const bf16* QKV = (const bf16*)(ws + WS_QKV);
    int tid_ = threadIdx.x; asm volatile("" : "+v"(tid_));
    const int tid = tid_, wid = __builtin_amdgcn_readfirstlane(tid >> 6), lane = tid & 63, r32 = lane & 31, hi = lane >> 5;
    const int d = cfg == 0 ? 1 : (cfg == 1 ? 4 : 16), nb = 16 / d, res = blk / nb, xb = blk % nb, U0 = 256 * xb + 32 * wid;
    fa::Blk B; B.Q = head_ptr(QKV, HB_QC + h, b) + (size_t)(res + d * U0) * HD; B.qstride = d * HD; B.kvstride = d * HD; B.qpos = U0;
    B.K = head_ptr(QKV, HB_KCC + h, b) + (size_t)res * HD; B.V = head_ptr(QKV, HB_VCC + h, b) + (size_t)res * HD; B.j_lo = xb ? 4 * xb - 2 : 0; B.j_hi = 4 * xb + 4;
    fa::Extra X{}; X.W = 129;
    fa::f32x16 o[4]; float m_reg, l_reg; float sc[16];
    fa::softmax_block<2>(lds, B, X, o, m_reg, l_reg);
    fa::row_scales(lds, wid, r32, hi, 1.0f / l_reg, sc);
    float* dout = (float*)(ws + WS_DO) + (size_t)cfg * MROWS * 1024 + (size_t)(b * SEQ + res + d * U0) * 1024 + h * 128;
#pragma unroll
    for (int r = 0; r < 16; ++r) { const int orow = fa::crow(r, hi);
#pragma unroll
        for (int d0 = 0; d0 < 4; ++d0) dout[(size_t)orow * d * 1024 + d0 * 32 + r32] = o[d0][r] * sc[r]; }
    if (hi == 0) ((float*)(ws + WS_LSE))[(size_t)cfg * MROWS * 8 + (size_t)(b * SEQ + res + d * (U0 + r32)) * 8 + h] = m_reg * fa::SCALE + logf(l_reg);
}
__device__ __forceinline__ void phaseZ_dil_combine(const Params& P, int gw, int NGW, int lane) {
    unsigned char* ws = P.ws;
    const float* DO = (const float*)(ws + WS_DO); const float* LSE = (const float*)(ws + WS_LSE);
    const int h = lane >> 3, c0 = (lane & 7) * 16;
    for (int row = gw; row < MROWS; row += NGW) {
        const float l0 = LSE[(size_t)row * 8 + h], l1 = LSE[(size_t)MROWS * 8 + (size_t)row * 8 + h], l2 = LSE[(size_t)2 * MROWS * 8 + (size_t)row * 8 + h];
        const float mx = fmaxf(l0, fmaxf(l1, l2)); float w0 = __expf(l0 - mx), w1 = __expf(l1 - mx), w2 = __expf(l2 - mx); const float inv = 1.0f / (w0 + w1 + w2); w0 *= inv; w1 *= inv; w2 *= inv;
        const float* p0 = DO + (size_t)row * 1024 + h * 128 + c0; const float* p1 = p0 + (size_t)MROWS * 1024; const float* p2 = p1 + (size_t)MROWS * 1024;
        unsigned char* dst = ws + WS_MIX + (size_t)row * MIXLD + MIXO8 + 1024 + h * 128 + c0;
#pragma unroll
        for (int q = 0; q < 2; ++q) { const f32x4 a0 = *(const f32x4*)(p0 + 8 * q), a1 = *(const f32x4*)(p0 + 8 * q + 4), b0 = *(const f32x4*)(p1 + 8 * q), b1 = *(const f32x4*)(p1 + 8 * q + 4), c0v = *(const f32x4*)(p2 + 8 * q), c1v = *(const f32x4*)(p2 + 8 * q + 4);
            const f32x4 o0 = a0 * w0 + b0 * w1 + c0v * w2, o1 = a1 * w0 + b1 * w1 + c1v * w2;
            v2u w; w.x = pk4_fp8(o0[0], o0[1], o0[2], o0[3]); w.y = pk4_fp8(o1[0], o1[1], o1[2], o1[3]);
            *(v2u*)(dst + 8 * q) = w; }
    }
}


constexpr int YQ_CMP = 256;
__device__ __forceinline__ void cmp_block(const Params& P, LAS char* lds, int b, int g, int qb) {
    using namespace fa;
    unsigned char* ws = P.ws;
    const bf16* QKV = (const bf16*)(ws + WS_QKV);
    const float* GATE = (const float*)(ws + WS_GATE);
    int tid_ = threadIdx.x; asm volatile("" : "+v"(tid_));
    const int tid = tid_, wid = __builtin_amdgcn_readfirstlane(tid >> 6), lane = tid & 63, r32 = lane & 31, hi = lane >> 5;
    const int tok = r32 >> 2, hh = r32 & 3, h = 4 * g + hh, bg = b * 2 + g;
    const int t = 64 * qb + 8 * wid + tok, row = b * SEQ + t;
    const bf16* qp = head_ptr(QKV, HB_QA + h, b) + (size_t)t * HD;
    bf16x8 qr[8];
#pragma unroll
    for (int d0 = 0; d0 < 8; ++d0) qr[d0] = *(const bf16x8*)(qp + d0 * 16 + hi * 8);
    Blk B{}; B.K = (const bf16*)(ws + WS_KC) + (size_t)bg * 256 * HD; B.V = (const bf16*)(ws + WS_VC) + (size_t)bg * 256 * HD; B.kvstride = HD;
    const int NT = (4 * qb + 66) >> 6;
    const int pos = (t >= 31 ? ((t - 15) >> 4) : 0) - 1, qm = pos - 4 * hi;
    const int tl = 64 * qb + 8 * wid + 7, posmax = (tl >= 31 ? ((tl - 15) >> 4) : 0) - 1;
    const int sr = tid >> 4, sc = (tid & 15) * 8, kws = FA_KSWZ(sr, sc * 2), vst0 = v_st(sr, sc), vst1 = v_st(32 + sr, sc);
    const int vb0 = (int)(unsigned)(size_t)(lds) + v_rd_base(lane);
    float m_reg = -1e30f, l_reg = 0.f, mn, alpha;
    Stage S; Extra X{};
    f32x16 p0, p1;
    stage_load<3>(S, B, X, 0, sr, sc, tid); asm volatile("s_waitcnt vmcnt(0)" ::: "memory"); stage_write<3>(S, lds, 0, kws, vst0, vst1, 0.f, tid); __syncthreads();
#define CMP_P1(T) if ((T) < NT) { \
        if ((T) + 1 < NT) stage_load<3>(S, B, X, (T) + 1, sr, sc, tid); \
        if (64 * (T) <= posmax) { FA_SBAR(); qkt<(T) & 1>(p0, p1, lds, r32, hi, qr); mask_tile(p0, p1, qm - 64 * (T), 1u << 30); partialSM(p0, p1, m_reg, mn, alpha); \
            float ps_ = 0.f; _Pragma("unroll") for (int r = 0; r < 16; ++r) ps_ += p0[r] + p1[r]; \
            { auto rr = __builtin_amdgcn_permlane32_swap(__float_as_uint(ps_), __float_as_uint(ps_), false, false); ps_ = __uint_as_float(rr[0]) + __uint_as_float(rr[1]); } \
            l_reg = l_reg * alpha + ps_; } \
        if ((T) + 1 < NT) { asm volatile("s_waitcnt vmcnt(0)" ::: "memory"); stage_write<3>(S, lds, ((T) & 1) ^ 1, kws, vst0, vst1, 0.f, tid); } \
        __syncthreads(); }
    CMP_P1(0) CMP_P1(1) CMP_P1(2) CMP_P1(3)
#undef CMP_P1
    const float inv_l = l_reg > 0.f ? 1.0f / l_reg : 0.f, mC = -m_reg * C2;
    f32x16 o[4];
#pragma unroll
    for (int d = 0; d < 4; ++d) o[d] = f32x16{};
    float IMP[4][8];
#pragma unroll
    for (int a = 0; a < 4; ++a)
#pragma unroll
        for (int k = 0; k < 8; ++k) IMP[a][k] = 0.f;
    bf16x8 pa0, pa1, pa2, pa3;
    stage_load<3>(S, B, X, 0, sr, sc, tid); asm volatile("s_waitcnt vmcnt(0)" ::: "memory"); stage_write<3>(S, lds, 0, kws, vst0, vst1, 0.f, tid); __syncthreads();
#define CMP_P2(T) if ((T) < NT) { \
        if ((T) + 1 < NT) stage_load<3>(S, B, X, (T) + 1, sr, sc, tid); \
        if (64 * (T) <= posmax) { FA_SBAR(); qkt<(T) & 1>(p0, p1, lds, r32, hi, qr); mask_tile(p0, p1, qm - 64 * (T), 1u << 30); \
            _Pragma("unroll") for (int r = 0; r < 16; ++r) { p0[r] = __builtin_amdgcn_exp2f(fmaf(p0[r], C2, mC)) * inv_l; p1[r] = __builtin_amdgcn_exp2f(fmaf(p1[r], C2, mC)) * inv_l; } \
            float A_[8], R_[8]; \
            _Pragma("unroll") for (int k = 0; k < 4; ++k) { A_[k] = p0[4 * k] + 2.f * (p0[4 * k + 1] + p0[4 * k + 2] + p0[4 * k + 3]); A_[4 + k] = p1[4 * k] + 2.f * (p1[4 * k + 1] + p1[4 * k + 2] + p1[4 * k + 3]); \
                R_[k] = swap32(p0[4 * k], hi); R_[4 + k] = swap32(p1[4 * k], hi); } \
            _Pragma("unroll") for (int k = 0; k < 8; ++k) IMP[T][k] += A_[k] + (hi ? (k < 7 ? R_[k < 7 ? k + 1 : 7] : 0.f) : R_[k]); \
            if ((T) > 0) IMP[(T) > 0 ? (T) - 1 : 0][7] += hi ? R_[0] : 0.f; \
            FA_PK4(p0, 0, pa0); FA_PK4(p0, 8, pa1); FA_PK4(p1, 0, pa2); FA_PK4(p1, 8, pa3); FA_SBAR(); \
            pv_tile<(T) & 1>(o, vb0, pa0, pa1, pa2, pa3); } \
        if ((T) + 1 < NT) { asm volatile("s_waitcnt vmcnt(0)" ::: "memory"); stage_write<3>(S, lds, ((T) & 1) ^ 1, kws, vst0, vst1, 0.f, tid); } \
        __syncthreads(); }
    CMP_P2(0) CMP_P2(1) CMP_P2(2) CMP_P2(3)
#undef CMP_P2
    { float scl[16]; const float g0 = sigmoidf_(GATE[(size_t)row * 32 + 3 * h]);
      row_scales(lds, wid, r32, hi, g0, scl);
      float* oc = (float*)(ws + WS_OCMP) + (size_t)(b * SEQ + 64 * qb + 8 * wid) * 1024 + 4 * g * 128;
#pragma unroll
      for (int r = 0; r < 16; ++r) { const int orow = crow(r, hi);
#pragma unroll
          for (int d0 = 0; d0 < 4; ++d0) oc[(size_t)(orow >> 2) * 1024 + (orow & 3) * 128 + d0 * 32 + r32] = o[d0][r] * scl[r]; } }
    unsigned long long* SELp = (unsigned long long*)(ws + WS_SEL) + (size_t)bg * SEQ + 64 * qb + 8 * wid;
    if (qb < 16) { if (lane < 8) SELp[lane] = 0xFFFFull; }
    else {
        LAS float* scs = (LAS float*)(lds + 73728) + wid * 512;
#pragma unroll
        for (int a = 0; a < 4; ++a)
#pragma unroll
            for (int k = 0; k < 8; ++k) { float v = IMP[a][k]; v += __shfl_xor(v, 1); v += __shfl_xor(v, 2); if (hh == 0) scs[tok * 64 + 16 * a + 2 * k + hi] = v; }
        asm volatile("s_waitcnt lgkmcnt(0)" ::: "memory");
        const int j = lane; const bool causal = j <= qb, forced = (j == 0) || (j == qb) || (j == qb - 1);
        for (int tk = 0; tk < 8; ++tk) {
            const float imp = scs[tk * 64 + lane];
            const float score = causal ? (forced ? 1e9f : imp) : -1.f;
            int rank = 0;
#pragma unroll 16
            for (int jj = 0; jj < 64; ++jj) { const float sj = __shfl(score, jj); rank += (sj > score || (sj == score && jj < j)) ? 1 : 0; }
            const unsigned long long mask = __ballot(rank < 16);
            if (lane == 0) SELp[tk] = mask;
        }
        asm volatile("s_waitcnt lgkmcnt(0)" ::: "memory");
    }
}
namespace pg8 {
struct CmpOrder {
    int c;
    __device__ __forceinline__ bool next(int i, Unit& u) const { if (i != 0 || c >= 8) return false; u.pm = c; u.pn = c >> 2; u.idx = 0; return true; }
    __device__ __forceinline__ void a_ready(const Unit&) const {}
    __device__ __forceinline__ void done(const Unit&) const {}
};
struct EpiCmp {
    static constexpr bool PERM = true, AFTER_DRAIN = true;
    bf16_t* hid; const bf16_t* w2t; const PG8_LAS float* bias; bf16_t* kcb; bf16_t* vcb;
    __device__ __forceinline__ void fused(f32x4 (&acc)[2][2][4][2], const Unit& u, int wr, int wc, int fr, int fq, PG8_LAS unsigned char* lds, int wid, int lane) const {
        const int kv = u.pn, row0 = u.pm * BM + wr * 64 + fr;
#pragma unroll
        for (int bj = 0; bj < 2; ++bj) { const int col = bj * HALF + wc * 32 + 8 * fq;
            const f32x4 b0 = *(const PG8_LAS f32x4*)(bias + col), b1 = *(const PG8_LAS f32x4*)(bias + col + 4);
#pragma unroll
            for (int ai = 0; ai < 2; ++ai)
#pragma unroll
                for (int m = 0; m < 4; ++m) { f32x4 v0 = acc[ai][bj][m][0] + b0, v1 = acc[ai][bj][m][1] + b1;
#pragma unroll
                    for (int i = 0; i < 4; ++i) { { const float x = v0[i], uu = 0.7978845608028654f * (x + 0.044715f * x * x * x), e = __expf(2.f * uu); v0[i] = 0.5f * x * (1.0f + (1.0f - 2.0f / (e + 1.0f))); }
                                                  { const float x = v1[i], uu = 0.7978845608028654f * (x + 0.044715f * x * x * x), e = __expf(2.f * uu); v1[i] = 0.5f * x * (1.0f + (1.0f - 2.0f / (e + 1.0f))); } }
                    u32x4 w; w.x = cvt_pk_bf16(v0[0], v0[1]); w.y = cvt_pk_bf16(v0[2], v0[3]); w.z = cvt_pk_bf16(v1[0], v1[1]); w.w = cvt_pk_bf16(v1[2], v1[3]);
                    *(u32x4*)(hid + (size_t)(row0 + ai * HALF + m * 16) * 256 + col) = w; } }
        asm volatile("s_waitcnt vmcnt(0)" ::: "memory"); __syncthreads();
        __builtin_amdgcn_fence(__ATOMIC_ACQUIRE, "agent"); asm volatile("s_waitcnt vmcnt(0)" ::: "memory");
        typedef float f32x16 __attribute__((ext_vector_type(16)));
        const int r32 = lane & 31, hi = lane >> 5;
        const bf16_t* hp = hid + (size_t)(u.pm * BM + wid * 32 + r32) * 256 + hi * 8;
        const bf16_t* wp = w2t + (size_t)kv * 128 * 256 + (size_t)r32 * 256 + hi * 8;
        f32x16 c2[4];
#pragma unroll
        for (int nt = 0; nt < 4; ++nt) c2[nt] = f32x16{};
#pragma unroll 4
        for (int ks = 0; ks < 16; ++ks) { const bf16x8 a = *(const bf16x8*)(hp + ks * 16);
#pragma unroll
            for (int nt = 0; nt < 4; ++nt) { const bf16x8 bb = *(const bf16x8*)(wp + (size_t)nt * 32 * 256 + ks * 16); c2[nt] = __builtin_amdgcn_mfma_f32_32x32x16_bf16(a, bb, c2[nt], 0, 0, 0); } }
        const int g = (u.pm >> 1) & 1, b = u.pm & 1, bgd = b * 2 + g;
        bf16_t* dst = (kv ? vcb : kcb) + (size_t)bgd * 256 * 128;
#pragma unroll
        for (int nt = 0; nt < 4; ++nt)
#pragma unroll
            for (int r = 0; r < 16; ++r) { const int crow_ = (r & 3) + 8 * (r >> 2) + 4 * hi; const float v = c2[nt][r];
                dst[(size_t)(wid * 32 + crow_) * 128 + nt * 32 + r32] = (bf16_t)((__builtin_bit_cast(unsigned, v) + 0x7fffu + ((__builtin_bit_cast(unsigned, v) >> 16) & 1u)) >> 16); }
    }
};
}


constexpr int XQ_SB = 256, XQ_TOTAL = XQ_SB + YQ_DIL, ZQ_TOTAL = 512;
__constant__ unsigned short ZTAB[ZQ_TOTAL] = {252, 253, 254, 255, 248, 249, 250, 251, 244, 245, 246, 247, 240, 241, 242, 243, 236, 237, 238, 239, 232, 233, 234, 235, 228, 229, 230, 231, 224, 225, 226, 227, 220, 221, 222, 223, 216, 217, 218, 219, 212, 213, 214, 215, 208, 209, 210, 211, 33008, 33009, 33010, 33011, 33012, 33013, 33014, 33015, 33016, 33017, 33018, 33019, 33020, 33021, 33022, 33023, 204, 205, 206, 207, 200, 201, 202, 203, 196, 197, 198, 199, 192, 193, 194, 195, 32992, 32993, 32994, 32995, 32996, 32997, 32998, 32999, 33000, 33001, 33002, 33003, 33004, 33005, 33006, 33007, 188, 189, 190, 191, 184, 185, 186, 187, 180, 181, 182, 183, 176, 177, 178, 179, 32976, 32977, 32978, 32979, 32980, 32981, 32982, 32983, 32984, 32985, 32986, 32987, 32988, 32989, 32990, 32991, 172, 173, 174, 175, 168, 169, 170, 171, 164, 165, 166, 167, 160, 161, 162, 163, 32960, 32961, 32962, 32963, 32964, 32965, 32966, 32967, 32968, 32969, 32970, 32971, 32972, 32973, 32974, 32975, 156, 157, 158, 159, 152, 153, 154, 155, 148, 149, 150, 151, 144, 145, 146, 147, 32944, 32945, 32946, 32947, 32948, 32949, 32950, 32951, 32952, 32953, 32954, 32955, 32956, 32957, 32958, 32959, 140, 141, 142, 143, 136, 137, 138, 139, 132, 133, 134, 135, 128, 129, 130, 131, 32928, 32929, 32930, 32931, 32932, 32933, 32934, 32935, 32936, 32937, 32938, 32939, 32940, 32941, 32942, 32943, 124, 125, 126, 127, 120, 121, 122, 123, 116, 117, 118, 119, 112, 113, 114, 115, 32912, 32913, 32914, 32915, 32916, 32917, 32918, 32919, 32920, 32921, 32922, 32923, 32924, 32925, 32926, 32927, 108, 109, 110, 111, 104, 105, 106, 107, 100, 101, 102, 103, 96, 97, 98, 99, 32896, 32897, 32898, 32899, 32900, 32901, 32902, 32903, 32904, 32905, 32906, 32907, 32908, 32909, 32910, 32911, 92, 93, 94, 95, 88, 89, 90, 91, 84, 85, 86, 87, 80, 81, 82, 83, 32880, 32881, 32882, 32883, 32884, 32885, 32886, 32887, 32888, 32889, 32890, 32891, 32892, 32893, 32894, 32895, 76, 77, 78, 79, 72, 73, 74, 75, 68, 69, 70, 71, 64, 65, 66, 67, 32864, 32865, 32866, 32867, 32868, 32869, 32870, 32871, 32872, 32873, 32874, 32875, 32876, 32877, 32878, 32879, 60, 61, 62, 63, 56, 57, 58, 59, 52, 53, 54, 55, 48, 49, 50, 51, 32848, 32849, 32850, 32851, 32852, 32853, 32854, 32855, 32856, 32857, 32858, 32859, 32860, 32861, 32862, 32863, 44, 45, 46, 47, 40, 41, 42, 43, 36, 37, 38, 39, 32, 33, 34, 35, 32832, 32833, 32834, 32835, 32836, 32837, 32838, 32839, 32840, 32841, 32842, 32843, 32844, 32845, 32846, 32847, 28, 29, 30, 31, 24, 25, 26, 27, 20, 21, 22, 23, 16, 17, 18, 19, 32816, 32817, 32818, 32819, 32820, 32821, 32822, 32823, 32824, 32825, 32826, 32827, 32828, 32829, 32830, 32831, 12, 13, 14, 15, 8, 9, 10, 11, 4, 5, 6, 7, 0, 1, 2, 3, 32800, 32801, 32802, 32803, 32804, 32805, 32806, 32807, 32808, 32809, 32810, 32811, 32812, 32813, 32814, 32815, 32784, 32785, 32786, 32787, 32788, 32789, 32790, 32791, 32792, 32793, 32794, 32795, 32796, 32797, 32798, 32799, 32768, 32769, 32770, 32771, 32772, 32773, 32774, 32775, 32776, 32777, 32778, 32779, 32780, 32781, 32782, 32783};
__device__ __forceinline__ int queue_pop(LAS char* lds, unsigned* qctr) {
    volatile LAS int* qslot = (volatile LAS int*)(lds + fa::L_MISC);
    if (threadIdx.x == 0) qslot[0] = (int)__hip_atomic_fetch_add(qctr, 1u, __ATOMIC_RELAXED, __HIP_MEMORY_SCOPE_AGENT);
    __syncthreads();
    const int item = __builtin_amdgcn_readfirstlane(qslot[0]);
    __syncthreads();
    return item;
}
__device__ __forceinline__ void phaseX_queue(const Params& P, LAS unsigned char* lds_, unsigned* qctr) {
    LAS char* lds = (LAS char*)lds_;
    for (;;) {
        const int item = queue_pop(lds, qctr);
        if (item >= XQ_TOTAL) break;
        if (item < XQ_SB) { const int bh = item & 15, x = 15 - (item >> 4); sbk_block(P, lds, bh >> 3, bh & 7, x); }
        else { const int it = item - XQ_SB, cfg = it / 256, r = it % 256, bh = r & 15, blk = r >> 4; dil_block(P, lds, cfg, bh >> 3, bh & 7, blk); }
    }
}
__device__ __forceinline__ void phaseZ_queue(const Params& P, LAS unsigned char* lds_, unsigned* qctr) {
    LAS char* lds = (LAS char*)lds_;
    for (;;) {
        const int item = queue_pop(lds, qctr);
        if (item >= ZQ_TOTAL) break;
        const unsigned code = ZTAB[item];
        if ((code >> 15) == 0u) { const int bg = code & 3, qb = (code >> 2) & 63;
            cmp_block(P, lds, bg >> 1, bg & 1, qb);
            asm volatile("s_waitcnt vmcnt(0)" ::: "memory"); __syncthreads(); __builtin_amdgcn_fence(__ATOMIC_ACQUIRE, "agent"); asm volatile("s_waitcnt vmcnt(0)" ::: "memory");
            nsa_block(P, lds, bg >> 1, bg & 1, qb); }
        else { const int bh = code & 15, x = (code >> 4) & 15; fox_block(P, lds, bh >> 3, bh & 7, x); }
    }
}

__device__ __forceinline__ void cumsum_wave(const Params& P, int l, int idx, int lane) {
    unsigned char* ws = P.ws; const float* GATE = (const float*)(ws + WS_GATE);
    const int b = idx >> 3, h = idx & 7; const float fb = ((const float*)P.in[I_FOXB])[l * 8 + h];
    float* cum = (float*)(ws + WS_CUM) + (size_t)idx * SEQ;
    double s = 0.0;
    for (int i = 0; i < 64; ++i) { const int t = lane * 64 + i; s += (double)log_sigmoid_f(GATE[(size_t)(b * SEQ + t) * 32 + 24 + h] + fb); }
    double incl = s;
#pragma unroll
    for (int o = 1; o < 64; o <<= 1) { const double y = __shfl_up(incl, o); if (lane >= o) incl += y; }
    double run = incl - s;
    for (int i = 0; i < 64; ++i) { const int t = lane * 64 + i; run += (double)log_sigmoid_f(GATE[(size_t)(b * SEQ + t) * 32 + 24 + h] + fb); cum[t] = (float)run; }
}

#ifndef REP_PHASE
#define REP_PHASE (-1)
#endif
#define NREP(k) (((k) == REP_PHASE) ? 2 : 1)
template <int l>
__device__ __forceinline__ void layer_phases(const Params& P, LAS unsigned char* lds, const XcdBarrier& bar, const int lo, const int hi) {
    int tid_ = threadIdx.x; asm volatile("" : "+v"(tid_));
    const int tid = tid_, lane = tid & 63, wave = __builtin_amdgcn_readfirstlane(tid >> 6);
    const int G = gridDim.x, blk = blockIdx.x;
    const int gw = blk * NWAVES + wave, NGW = G * NWAVES;
    unsigned char* ws = P.ws;
#define IN(k) (lo <= (k) && (k) < hi)
#define SEAM(k) do { if ((k) + 1 < hi) xcd_barrier(bar); } while (0)
#define PHASE(k) if (IN(k)) for (int rep = 0; rep < NREP(k); ++rep)
#define REPBAR() do { if (rep) xcd_barrier(bar); } while (0)
    const int pb = 1 + PH_PER_LAYER * l;
    unsigned char* wl = ws + WS_W + (size_t)l * LAYER_W;
    bf16* H = (bf16*)(ws + WS_H);
    const void* hin = l == 0 ? (const void*)P.in[I_X] : (const void*)H;
    bf16* XN = (bf16*)(ws + WS_XN);
    float* SSA = (float*)(ws + WS_SSA); float* SSB = (float*)(ws + WS_SSB);
    unsigned* qc = (unsigned*)(ws + WS_CTL) + 64 * (8 + 8 * l);
    PHASE(pb + 0) { REPBAR();
        { pg8::Gemm g{(const bf16*)(ws + WS_XN8), (const bf16*)(wl + W_IN + W_IN8), MROWS, N8P * 256, DM}; pg8::StaticOrder S; S.init(MROWS, N8P * 256, G, blk);
          if (l > 0) rstd_prepass(lds, S, SSA);
          pg8::EpiProj<(l > 0), true> E{(bf16*)(ws + WS_QKV), (float*)(ws + WS_GATE), (const float*)(ws + WS_ROPE), (const LAS float*)(lds + LRSTD_OFF)};
          pg8::gemm_phase<pg8::EpiProj<(l > 0), true>, pg8::StaticOrder, true, true, true, 0x79797979>(lds + RING_OFF, g, S, E); }
        { pg8::Gemm g{l == 0 ? XN : (const bf16*)H, (const bf16*)(wl + W_IN), MROWS, N16P * 256, DM}; pg8::StaticOrder S; S.init(MROWS, N16P * 256, G, blk);
          if (l > 0) rstd_prepass(lds, S, SSA);
          pg8::EpiProj<(l > 0), false> E{(bf16*)(ws + WS_QKV), (float*)(ws + WS_GATE), (const float*)(ws + WS_ROPE), (const LAS float*)(lds + LRSTD_OFF)};
          pg8::gemm_phase<pg8::EpiProj<(l > 0), false>, pg8::StaticOrder, true, true>(lds + RING_OFF, g, S, E); } }
    if (IN(pb + 0)) SEAM(pb + 0);
    PHASE(pb + 1) { REPBAR();
        if (blk < 8) { LAS float* lbias = (LAS float*)(lds + LDSCTL_OFF + 1024); const int kv = blk >> 2;
            if (tid < 256) { const float* p = (const float*)(ws + WS_CBP) + (size_t)((l * 2 + kv) * 64) * 256 + tid; float s = 0.f;
#pragma unroll 16
                for (int kc = 0; kc < 64; ++kc) s += p[(size_t)kc * 256];
                lbias[tid] = s; }
            __syncthreads();
            pg8::Gemm g{(const bf16*)(ws + WS_QKV) + (size_t)16 * SEQ * HD, (const bf16*)(wl + W_C1K), 2048, 512, 4096, 2048, 4096}; pg8::CmpOrder S{blk};
            pg8::EpiCmp E{(bf16*)(ws + WS_HID), (const bf16*)(wl + W_C2K), (const LAS float*)lbias, (bf16*)(ws + WS_KC), (bf16*)(ws + WS_VC)};
            pg8::gemm_phase<pg8::EpiCmp, pg8::CmpOrder, false, true>(lds + RING_OFF, g, S, E);
            }
        if (gw >= 64 && gw < 80) cumsum_wave(P, l, gw - 64, lane);
        __syncthreads();
        phaseX_queue(P, lds, qc + 64 * rep); }
    if (IN(pb + 1)) SEAM(pb + 1);
    PHASE(pb + 2) { REPBAR(); phaseZ_dil_combine(P, gw, NGW, lane); phaseZ_queue(P, lds, qc + 128 + 64 * rep); }
    if (IN(pb + 2)) SEAM(pb + 2);
    PHASE(pb + 3) { REPBAR();
        pg8::Gemm2 g{ws + WS_MIX, wl + W_O, MIXLD, MIXO8, 2048, 2048}; pg8::StaticOrder S; S.init(MROWS, DM, G, blk);
        pg8::EpiResid<(l == 0), false> E{hin, H, DM, nullptr, SSA};
        pg8::gemm_phase_mixed<pg8::EpiResid<(l == 0), false>, pg8::StaticOrder, 0x79797979>(lds + RING_OFF, g, S, E); }
    if (IN(pb + 3)) SEAM(pb + 3);
    PHASE(pb + 4) { REPBAR();
        pg8::Gemm g{H, (const bf16*)(wl + W_UP), MROWS, DFF, DM}; pg8::StaticOrder S; S.init(MROWS, DFF, G, blk);
        rstd_prepass(lds, S, SSA);
        pg8::EpiAct<2> E{(bf16*)(ws + WS_FF), DFF, (const LAS float*)(lds + LRSTD_OFF)};
        pg8::gemm_phase<pg8::EpiAct<2>, pg8::StaticOrder, true, true>(lds + RING_OFF, g, S, E); }
    if (IN(pb + 4)) SEAM(pb + 4);
    PHASE(pb + 5) { REPBAR();
        pg8::Gemm g{(const bf16*)(ws + WS_FF), (const bf16*)(wl + W_DN), MROWS, DM, DFF}; pg8::StaticOrder S; S.init(MROWS, DM, G, blk);
        pg8::EpiResid<false, true> E{H, H, DM, (unsigned char*)XN, SSB};
        pg8::gemm_phase<pg8::EpiResid<false, true>, pg8::StaticOrder, true, true>(lds + RING_OFF, g, S, E); }
    if (IN(pb + 5)) SEAM(pb + 5);
    PHASE(pb + 6) { REPBAR();
        { pg8::Gemm g{(const bf16*)(ws + WS_PB) + (size_t)l * MROWS * PLE, (const bf16*)(wl + W_PP), MROWS, DM, PLE}; pg8::StaticOrder S; S.init(MROWS, DM, G, blk);
          pg8::EpiAct<0> E{(bf16*)(ws + WS_PP), DM, nullptr};
          pg8::gemm_phase<pg8::EpiAct<0>, pg8::StaticOrder, true, true>(lds + RING_OFF, g, S, E); }
        VM_WAIT(); __builtin_amdgcn_fence(__ATOMIC_ACQUIRE, "agent"); VM_WAIT(); __syncthreads();
        { pg8::Gemm g{XN, (const bf16*)(wl + W_G), MROWS, DM, DM}; pg8::StaticOrder S; S.init(MROWS, DM, G, blk);
          rstd_prepass(lds, S, SSB);
          pg8::EpiPle<(l + 1 < DEPTH)> E{H, (const bf16*)(ws + WS_PP), DM, (const LAS float*)(lds + LRSTD_OFF), SSA, ws + WS_XN8};
          pg8::gemm_phase<pg8::EpiPle<(l + 1 < DEPTH)>, pg8::StaticOrder, true, true, true, 0x79797979>(lds + RING_OFF, g, S, E); } }
    if (IN(pb + 6)) SEAM(pb + 6);
#undef IN
#undef SEAM
#undef PHASE
#undef REPBAR
}


__global__ void __launch_bounds__(NTHREADS, 2) hybrid_fwd(Params P) {
    extern __shared__ __attribute__((aligned(16))) unsigned char lds_raw[];
    LAS unsigned char* lds = (LAS unsigned char*)lds_raw;
    volatile LAS unsigned* MISC = (volatile LAS unsigned*)(lds + MISC_OFF);
    const int tid = threadIdx.x, lane = tid & 63, wave = __builtin_amdgcn_readfirstlane(tid >> 6);
    const int G = gridDim.x, blk = blockIdx.x;
    const int gw = blk * NWAVES + wave, NGW = G * NWAVES;
    unsigned char* ws = P.ws;
    for (int u = tid; u < (LDS_BYTES - LDSCTL_OFF) / 4; u += NTHREADS) ((LAS unsigned*)(lds + LDSCTL_OFF))[u] = 0u;
    __syncthreads();
    XcdBarrier bar = xcd_barrier_post((unsigned*)(ws + WS_CTL) + CW_BAR, MISC + 8);
    const int lo = P.ph_lo, hi = P.ph_hi;
#define IN(k) (lo <= (k) && (k) < hi)
#define SEAM(k) do { if ((k) + 1 < hi) xcd_barrier(bar); } while (0)

    #ifndef NO_P0
    if (IN(0)) { for (int rep = 0; rep < NREP(0); ++rep) { if (rep) xcd_barrier(bar); prologue_phase(P, lds, gw, NGW, wave, lane, rep); } SEAM(0); }
#endif

    layer_phases<0>(P, lds, bar, lo, hi);
    layer_phases<1>(P, lds, bar, lo, hi);
    if (IN(NPH - 1)) {
        norm_phase<true, true>((const float*)(ws + WS_H), (const float*)P.in[I_NFIN], P.out, gw, NGW, lane);
    }
#undef IN
#undef SEAM
}

#ifndef N_LAUNCH_MODE
#define N_LAUNCH_MODE 1
#endif
extern "C" void kernel_launch(void* const* d_in, const int* in_sizes, int n_in, void* d_out, int out_size, void* d_ws, size_t ws_size, hipStream_t stream) {
    static int grid = 0;
    if (grid == 0) {
        if (n_in != 20 || in_sizes[0] != MROWS * DM || out_size != MROWS * DM || ws_size < WS_END) { fprintf(stderr, "kernel_launch: unexpected shapes (n_in %d, in0 %d, out %d, ws %zu)\n", n_in, n_in > 0 ? in_sizes[0] : -1, out_size, ws_size); grid = -1; return; }
        int dev = 0, cus = 0, per_cu = 0;
        if (hipGetDevice(&dev) != hipSuccess || hipDeviceGetAttribute(&cus, hipDeviceAttributeMultiprocessorCount, dev) != hipSuccess) { grid = -1; return; }
        if (hipFuncSetAttribute((const void*)hybrid_fwd, hipFuncAttributeMaxDynamicSharedMemorySize, LDS_BYTES) != hipSuccess) { fprintf(stderr, "kernel_launch: hipFuncSetAttribute failed\n"); grid = -1; return; }
        if (hipOccupancyMaxActiveBlocksPerMultiprocessor(&per_cu, (const void*)hybrid_fwd, NTHREADS, LDS_BYTES) != hipSuccess || per_cu < 1) fprintf(stderr, "kernel_launch: occupancy query reports %d\n", per_cu);
        (void)hipGetLastError();
        grid = cus;
    }
    if (grid < 0) return;
    if (hipMemsetAsync((char*)d_ws + WS_CTL, 0, CTL_ZERO_BYTES, stream) != hipSuccess) return;
    Params p{};
    for (int i = 0; i < 20; ++i) p.in[i] = d_in[i];
    p.out = (float*)d_out; p.ws = (unsigned char*)d_ws;
#if N_LAUNCH_MODE == 1
    p.ph_lo = 0; p.ph_hi = NPH;
    hipLaunchKernelGGL(hybrid_fwd, dim3(grid), dim3(NTHREADS), LDS_BYTES, stream, p);
#else
    for (int k = 0; k < NPH; ++k) { p.ph_lo = k; p.ph_hi = k + 1; hipLaunchKernelGGL(hybrid_fwd, dim3(grid), dim3(NTHREADS), LDS_BYTES, stream, p); }
#endif
}
```
